# Optimizing an MI355X kernel written in HIP

```python
import jax
import jax.numpy as jnp
from jax import lax
import numpy as np

D_MODEL = 1024
BATCH = 4
SEQ = 8192
DEPTH = 4

HEAD_DIM = 64
MIX_HEADS = 12
MIX_WIDTH = MIX_HEADS * HEAD_DIM
MEM_HEADS = 4
MEM_WIDTH = MEM_HEADS * HEAD_DIM
MEM_LEN = 256
CONV_WIDTH = 3
ROPE_DIM = HEAD_DIM // 4
ROPE_THETA = 500000.0
MOBA_BLOCK = 256
MOBA_TOPK = 3
MOBA_Q_CHUNK = 16
D_FF = 2816
N_EXPERTS = 8
TOP_K = 2
LN_EPS = 1e-5
N_A_LAYERS = DEPTH // 2
N_B_LAYERS = DEPTH - N_A_LAYERS
N_DENSE = (DEPTH + 1) // 2
N_MOE = DEPTH // 2
DEEPNORM_ALPHA = float((2 * DEPTH) ** 0.25)
DEEPNORM_BETA = float((8 * DEPTH) ** -0.25)
ATTN_SCALE = HEAD_DIM ** -0.5

kernel_name = 'hybrid_shortconv_moba_yoco_deepnorm_moe'


def layer_norm(x, g, b):
    xf = x.astype(jnp.float32)
    mu = jnp.mean(xf, axis=-1, keepdims=True)
    var = jnp.mean(jnp.square(xf - mu), axis=-1, keepdims=True)
    y = (xf - mu) * lax.rsqrt(var + LN_EPS)
    return (y * g + b).astype(x.dtype)


def rope_tables(positions):
    inv_freq = ROPE_THETA ** (-jnp.arange(0, ROPE_DIM, 2, dtype=jnp.float32) / ROPE_DIM)
    angles = positions.astype(jnp.float32)[..., None] * inv_freq
    return jnp.cos(angles)[:, :, None, :], jnp.sin(angles)[:, :, None, :]


def apply_partial_rope(t, cos, sin):
    half = ROPE_DIM // 2
    t1 = t[..., :half].astype(jnp.float32)
    t2 = t[..., half:ROPE_DIM].astype(jnp.float32)
    rot = jnp.concatenate([t1 * cos - t2 * sin, t2 * cos + t1 * sin], axis=-1).astype(t.dtype)
    return jnp.concatenate([rot, t[..., ROPE_DIM:]], axis=-1)


def short_conv_mixer(u_b, u_c, u_h, conv_w):
    z = u_c * u_h
    z = lax.conv_general_dilated(
        z, conv_w[:, None, :], window_strides=(1,), padding=[(CONV_WIDTH - 1, 0)],
        dimension_numbers=('NWC', 'WIO', 'NWC'), feature_group_count=MIX_WIDTH)
    return u_b * z


def memory_cross_attention(q, k, v):
    logits = jnp.einsum('bshd,bmhd->bhsm', q, k).astype(jnp.float32) * ATTN_SCALE
    probs = jax.nn.softmax(logits, axis=-1).astype(v.dtype)
    out = jnp.einsum('bhsm,bmhd->bshd', probs, v)
    return out.reshape(q.shape[0], q.shape[1], -1)


def shared_key_value(h, w_kv, cos, sin):
    bsz, seq, _ = h.shape
    kv = jnp.einsum('bsd,de->bse', h, w_kv)
    k = apply_partial_rope(kv[..., :MIX_WIDTH].reshape(bsz, seq, MIX_HEADS, HEAD_DIM), cos, sin)
    v = kv[..., MIX_WIDTH:].reshape(bsz, seq, MIX_HEADS, HEAD_DIM)
    pad = (-seq) % MOBA_BLOCK
    k = jnp.pad(k, ((0, 0), (0, pad), (0, 0), (0, 0)))
    v = jnp.pad(v, ((0, 0), (0, pad), (0, 0), (0, 0)))
    n_blocks = (seq + pad) // MOBA_BLOCK
    k_blocks = k.reshape(bsz, n_blocks, MOBA_BLOCK, MIX_HEADS, HEAD_DIM).transpose(0, 3, 1, 2, 4)
    v_blocks = v.reshape(bsz, n_blocks, MOBA_BLOCK, MIX_HEADS, HEAD_DIM).transpose(0, 3, 1, 2, 4)
    k_means = jnp.mean(k_blocks.astype(jnp.float32), axis=3).astype(k.dtype)
    return k_blocks, v_blocks, k_means


def moba_attention(q, k_blocks, v_blocks, k_means):
    bsz, seq, n_heads, head_dim = q.shape
    n_blocks = k_blocks.shape[2]
    topk = min(MOBA_TOPK, n_blocks)
    n_sel = topk * MOBA_BLOCK
    n_chunks = seq // MOBA_Q_CHUNK
    q_chunks = q.reshape(bsz, n_chunks, MOBA_Q_CHUNK, n_heads, head_dim).transpose(1, 0, 3, 2, 4)
    b_idx = jnp.arange(bsz)[:, None, None, None]
    h_idx = jnp.arange(n_heads)[None, :, None, None]
    block_ids = jnp.arange(n_blocks)

    def one_chunk(args):
        c, qc = args
        start = c * MOBA_Q_CHUNK
        own = start // MOBA_BLOCK
        q_pos = start + jnp.arange(MOBA_Q_CHUNK)
        gate = jnp.einsum('bhqd,bhnd->bhqn', qc, k_means).astype(jnp.float32)
        gate = jnp.where(block_ids < own, gate, -jnp.inf)
        _, sel = lax.top_k(gate, topk)
        sel_valid = sel < own
        k_sel = k_blocks[b_idx, h_idx, sel]
        v_sel = v_blocks[b_idx, h_idx, sel]
        k_own = lax.dynamic_index_in_dim(k_blocks, own, axis=2, keepdims=False)
        v_own = lax.dynamic_index_in_dim(v_blocks, own, axis=2, keepdims=False)
        s_sel = jnp.einsum('bhqd,bhqkjd->bhqkj', qc, k_sel).astype(jnp.float32) * ATTN_SCALE
        s_sel = jnp.where(sel_valid[..., None], s_sel, -jnp.inf)
        s_own = jnp.einsum('bhqd,bhjd->bhqj', qc, k_own).astype(jnp.float32) * ATTN_SCALE
        k_pos = own * MOBA_BLOCK + jnp.arange(MOBA_BLOCK)
        s_own = jnp.where(k_pos[None, :] <= q_pos[:, None], s_own, -jnp.inf)
        scores = jnp.concatenate([s_sel.reshape(bsz, n_heads, MOBA_Q_CHUNK, n_sel), s_own], axis=-1)
        probs = jax.nn.softmax(scores, axis=-1).astype(qc.dtype)
        p_sel = probs[..., :n_sel].reshape(bsz, n_heads, MOBA_Q_CHUNK, topk, MOBA_BLOCK)
        p_own = probs[..., n_sel:]
        return (jnp.einsum('bhqkj,bhqkjd->bhqd', p_sel, v_sel)
                + jnp.einsum('bhqj,bhjd->bhqd', p_own, v_own))

    out = lax.map(one_chunk, (jnp.arange(n_chunks), q_chunks))
    return out.transpose(1, 0, 3, 2, 4).reshape(bsz, seq, n_heads * head_dim)


def swiglu(x, w_gu, w_down):
    gu = jnp.einsum('bsd,df->bsf', x, w_gu)
    g, u = gu[..., :D_FF], gu[..., D_FF:]
    return jnp.einsum('bsf,fd->bsd', jax.nn.silu(g) * u, w_down)


def moe_swiglu(x, w_router, w_gu, w_down):
    logits = jnp.einsum('bsd,de->bse', x, w_router).astype(jnp.float32)
    top_logits, top_idx = lax.top_k(logits, TOP_K)
    top_gates = jax.nn.softmax(top_logits, axis=-1)
    gates = jnp.sum(jax.nn.one_hot(top_idx, N_EXPERTS, dtype=jnp.float32) * top_gates[..., None], axis=-2)
    gates = gates.astype(x.dtype)
    out = jnp.zeros_like(x)
    for e in range(N_EXPERTS):
        out = out + gates[..., e:e + 1] * swiglu(x, w_gu[e], w_down[e])
    return out


def setup_inputs(seed: int = 0) -> dict:
    key = jax.random.key(seed)
    ks = jax.random.split(key, 20)
    f32 = jnp.float32

    def nrm(k, shape, scale):
        return jax.random.normal(k, shape, f32) * scale

    x = nrm(ks[0], (BATCH, SEQ, D_MODEL), 1.0)
    mem = nrm(ks[1], (BATCH, MEM_LEN, D_MODEL), 1.0)
    offset = jax.random.randint(ks[2], (BATCH, 1), 0, 1024, dtype=jnp.int32)
    positions = offset + jnp.arange(SEQ, dtype=jnp.int32)[None, :]
    w_in_a = nrm(ks[3], (N_A_LAYERS, D_MODEL, 3 * MIX_WIDTH + MEM_WIDTH), D_MODEL ** -0.5)
    conv_a = nrm(ks[4], (N_A_LAYERS, CONV_WIDTH, MIX_WIDTH), CONV_WIDTH ** -0.5)
    w_q_b = nrm(ks[5], (N_B_LAYERS, D_MODEL, MIX_WIDTH + MEM_WIDTH), D_MODEL ** -0.5)
    w_kv_shared = nrm(ks[6], (D_MODEL, 2 * MIX_WIDTH), D_MODEL ** -0.5)
    w_mem_kv = nrm(ks[7], (DEPTH, D_MODEL, 2 * MEM_WIDTH), D_MODEL ** -0.5)
    w_o = nrm(ks[8], (DEPTH, MIX_WIDTH + MEM_WIDTH, D_MODEL), (MIX_WIDTH + MEM_WIDTH) ** -0.5 * DEEPNORM_BETA)
    ln1_g = 1.0 + nrm(ks[9], (DEPTH, D_MODEL), 0.02)
    ln1_b = nrm(ks[10], (DEPTH, D_MODEL), 0.02)
    ln2_g = 1.0 + nrm(ks[11], (DEPTH, D_MODEL), 0.02)
    ln2_b = nrm(ks[12], (DEPTH, D_MODEL), 0.02)
    w_gu_dense = nrm(ks[13], (N_DENSE, D_MODEL, 2 * D_FF), D_MODEL ** -0.5)
    w_down_dense = nrm(ks[14], (N_DENSE, D_FF, D_MODEL), D_FF ** -0.5 * DEEPNORM_BETA)
    w_router = nrm(ks[15], (N_MOE, D_MODEL, N_EXPERTS), D_MODEL ** -0.5)
    w_gu_moe = nrm(ks[16], (N_MOE, N_EXPERTS, D_MODEL, 2 * D_FF), D_MODEL ** -0.5)
    w_down_moe = nrm(ks[17], (N_MOE, N_EXPERTS, D_FF, D_MODEL), D_FF ** -0.5 * DEEPNORM_BETA)
    return {'x': x, 'mem': mem, 'positions': positions, 'w_in_a': w_in_a, 'conv_a': conv_a,
            'w_q_b': w_q_b, 'w_kv_shared': w_kv_shared, 'w_mem_kv': w_mem_kv, 'w_o': w_o,
            'ln1_g': ln1_g, 'ln1_b': ln1_b, 'ln2_g': ln2_g, 'ln2_b': ln2_b,
            'w_gu_dense': w_gu_dense, 'w_down_dense': w_down_dense, 'w_router': w_router,
            'w_gu_moe': w_gu_moe, 'w_down_moe': w_down_moe}


def reference(x, mem, positions, w_in_a, conv_a, w_q_b, w_kv_shared, w_mem_kv, w_o,
              ln1_g, ln1_b, ln2_g, ln2_b, w_gu_dense, w_down_dense, w_router,
              w_gu_moe, w_down_moe):
    bsz, seq, _ = x.shape
    cos, sin = rope_tables(positions)
    shared = None
    for layer in range(DEPTH):
        mem_kv = jnp.einsum('bmd,de->bme', mem, w_mem_kv[layer])
        mem_k = mem_kv[..., :MEM_WIDTH].reshape(bsz, -1, MEM_HEADS, HEAD_DIM)
        mem_v = mem_kv[..., MEM_WIDTH:].reshape(bsz, -1, MEM_HEADS, HEAD_DIM)
        if layer < N_A_LAYERS:
            proj = jnp.einsum('bsd,de->bse', x, w_in_a[layer])
            u_b = proj[..., :MIX_WIDTH]
            u_c = proj[..., MIX_WIDTH:2 * MIX_WIDTH]
            u_h = proj[..., 2 * MIX_WIDTH:3 * MIX_WIDTH]
            q_mem = proj[..., 3 * MIX_WIDTH:]
            main = short_conv_mixer(u_b, u_c, u_h, conv_a[layer])
        else:
            proj = jnp.einsum('bsd,de->bse', x, w_q_b[layer - N_A_LAYERS])
            q = apply_partial_rope(proj[..., :MIX_WIDTH].reshape(bsz, seq, MIX_HEADS, HEAD_DIM), cos, sin)
            q_mem = proj[..., MIX_WIDTH:]
            k_blocks, v_blocks, k_means = shared
            main = moba_attention(q, k_blocks, v_blocks, k_means)
        mem_out = memory_cross_attention(q_mem.reshape(bsz, seq, MEM_HEADS, HEAD_DIM), mem_k, mem_v)
        mix = jnp.einsum('bse,ed->bsd', jnp.concatenate([main, mem_out], axis=-1), w_o[layer])
        x = layer_norm(DEEPNORM_ALPHA * x + mix, ln1_g[layer], ln1_b[layer])
        if layer % 2 == 0:
            ffn = swiglu(x, w_gu_dense[layer // 2], w_down_dense[layer // 2])
        else:
            ffn = moe_swiglu(x, w_router[layer // 2], w_gu_moe[layer // 2], w_down_moe[layer // 2])
        x = layer_norm(DEEPNORM_ALPHA * x + ffn, ln2_g[layer], ln2_b[layer])
        if layer == N_A_LAYERS - 1:
            shared = shared_key_value(x, w_kv_shared, cos, sin)
    return x
```

```cpp
#include <hip/hip_runtime.h>
#include <cstdio>
#include <cstdint>
#include <cmath>
namespace pg8 {
#define PG8_LAS __attribute__((address_space(3)))
typedef unsigned short bf16_t;
typedef short bf16x8 __attribute__((ext_vector_type(8)));
typedef float f32x4 __attribute__((ext_vector_type(4)));
typedef unsigned u32x4 __attribute__((ext_vector_type(4)));
constexpr int BM = 256, BK = 64, HALF = 128, HTB = HALF * BK * 2  , STAGE_BYTES = 8 * HTB, NXCD = 8, WGM = 8;

__host__ __device__ __forceinline__ int lds_byte(int r, int c) { const int st = (r >> 4) * 2 + (c >> 5), rr = r & 15, cc = c & 31, ob = rr * 64 + cc * 2; return st * 1024 + (ob ^ (((ob >> 9) & 1) << 5)); }
__host__ __device__ __forceinline__ void stage_rc(int b, int& R, int& C) { const int st = b / 1024, sb = b % 1024, swz = sb ^ (((sb >> 9) & 1) << 5); R = (st >> 1) * 16 + swz / 64; C = (st & 1) * 32 + (swz % 64) / 2; }
__host__ __device__ __forceinline__ int perm32(int rho) { const int n = rho >> 4, i = rho & 15; return 8 * (i >> 2) + 4 * n + (i & 3); }

struct Unit { int pm, pn; };
struct Gemm { const bf16_t* A; const bf16_t* Bt; int M, N, K; };

struct PanelOrder {
    int nM, nN, nwg, G, c; int ps1, ps2, ps3, ps4, ps5, ps6, ps7; size_t estride;
    __device__ __forceinline__ void init(int nM_, int nN_, int G_, int c_) { nM = nM_; nN = nN_; nwg = nM * nN; G = G_; c = c_; ps1 = ps2 = ps3 = ps4 = ps5 = ps6 = ps7 = 0x7fffffff; estride = 0; }
    __device__ __forceinline__ bool next(int i, Unit& u) const {
        const long L = (long)i * G + c; if (L >= nwg) return false;
        int wgid = (int)L; { const int q = nwg / NXCD, r = nwg % NXCD, xcd = wgid % NXCD, off = wgid / NXCD; wgid = (xcd < r ? xcd * (q + 1) : r * (q + 1) + (xcd - r) * q) + off; }
        const int nig = WGM * nN, gid = wgid / nig, fm = gid * WGM, gsz = (nM - fm) < WGM ? (nM - fm) : WGM;
        u.pm = fm + ((wgid % nig) % gsz); u.pn = (wgid % nig) / gsz; return true;
    }
    __device__ __forceinline__ size_t boff(const Unit& u) const {
        const int e = (int)(u.pm >= ps1) + (int)(u.pm >= ps2) + (int)(u.pm >= ps3) + (int)(u.pm >= ps4) + (int)(u.pm >= ps5) + (int)(u.pm >= ps6) + (int)(u.pm >= ps7);
        return (size_t)e * estride;
    }
    __device__ __forceinline__ void a_ready(const Unit&) const {}
    __device__ __forceinline__ void done(const Unit&) const {}
};
__device__ __forceinline__ unsigned cvt_pk_bf16(float lo, float hi) { unsigned r; asm volatile("v_cvt_pk_bf16_f32 %0, %1, %2" : "=v"(r) : "v"(lo), "v"(hi)); return r; }
typedef float f32x2 __attribute__((ext_vector_type(2)));
typedef float f32x2 __attribute__((ext_vector_type(2)));
struct EpiBf16 {
    static constexpr bool PERM = true, AFTER_DRAIN = false;
    bf16_t* O; int ldc; int split_cols; size_t split_stride;
    __device__ __forceinline__ void operator()(const f32x4 (&acc)[2][2][4][2], const Unit& u, int wr, int wc, int fr, int fq) const {
        const int row0 = u.pm * BM + wr * 64 + fr; int colt = u.pn * BM; bf16_t* base = O;
        if (split_cols) { const int t = colt / split_cols; base += (size_t)t * split_stride; colt -= t * split_cols; }
        const int col0 = colt + wc * 32 + 8 * fq;
#pragma unroll
        for (int ai = 0; ai < 2; ++ai)
#pragma unroll
            for (int m = 0; m < 4; ++m) { bf16_t* rowp = base + (size_t)(row0 + ai * HALF + m * 16) * ldc + col0;
#pragma unroll
                for (int bj = 0; bj < 2; ++bj) { const f32x4 v0 = acc[ai][bj][m][0], v1 = acc[ai][bj][m][1];
                    u32x4 w; w.x = cvt_pk_bf16(v0[0], v0[1]); w.y = cvt_pk_bf16(v0[2], v0[3]); w.z = cvt_pk_bf16(v1[0], v1[1]); w.w = cvt_pk_bf16(v1[2], v1[3]);
                    *(u32x4*)(rowp + bj * HALF) = w; } }
    }
};
__device__ __forceinline__ float silu_mul(float g, float u) { const float e = __builtin_amdgcn_exp2f(g * -1.4426950408889634f); return g * __builtin_amdgcn_rcpf(1.0f + e) * u; }
struct EpiGlu {
    static constexpr bool PERM = true, AFTER_DRAIN = false;
    bf16_t* O; int ldc;
    __device__ __forceinline__ void operator()(const f32x4 (&acc)[2][2][4][2], const Unit& u, int wr, int wc, int fr, int fq) const {
        const int row0 = u.pm * BM + wr * 64 + fr; const int col0 = u.pn * HALF + wc * 32 + 8 * fq;
#pragma unroll
        for (int ai = 0; ai < 2; ++ai)
#pragma unroll
            for (int m = 0; m < 4; ++m) { bf16_t* rowp = O + (size_t)(row0 + ai * HALF + m * 16) * ldc + col0;
                const f32x4 g0 = acc[ai][0][m][0], g1 = acc[ai][0][m][1], u0 = acc[ai][1][m][0], u1 = acc[ai][1][m][1];
                u32x4 w; w.x = cvt_pk_bf16(silu_mul(g0[0], u0[0]), silu_mul(g0[1], u0[1])); w.y = cvt_pk_bf16(silu_mul(g0[2], u0[2]), silu_mul(g0[3], u0[3]));
                w.z = cvt_pk_bf16(silu_mul(g1[0], u1[0]), silu_mul(g1[1], u1[1])); w.w = cvt_pk_bf16(silu_mul(g1[2], u1[2]), silu_mul(g1[3], u1[3]));
                *(u32x4*)rowp = w; }
    }
};
struct EpiRes {
    static constexpr bool PERM = false, AFTER_DRAIN = false;
    const float* base; float* out; int ldc; float alpha;
    __device__ __forceinline__ void operator()(const f32x4 (&acc)[2][2][4][2], const Unit& u, int wr, int wc, int fr, int fq) const {
        const int col0 = u.pn * BM + wc * 32 + 4 * fq;
#pragma unroll
        for (int ai = 0; ai < 2; ++ai)
#pragma unroll
            for (int m = 0; m < 4; ++m) { const size_t off = (size_t)(u.pm * BM + ai * HALF + wr * 64 + m * 16 + fr) * ldc + col0;
#pragma unroll
                for (int bj = 0; bj < 2; ++bj)
#pragma unroll
                    for (int n = 0; n < 2; ++n) { const f32x4 bs = *(const f32x4*)(base + off + bj * HALF + n * 16); const f32x4 o = bs * alpha + acc[ai][bj][m][n]; *(f32x4*)(out + off + bj * HALF + n * 16) = o; }
                if (m & 1) asm volatile("" ::: "memory"); }
    }
};

template <class Epi, class Sched, bool ALIGN_EPI = false, bool SP2 = false>
__device__ __forceinline__ void gemm_phase(PG8_LAS unsigned char* lds, const Gemm g, const Sched& S, const Epi& E) {
    int tid_ = threadIdx.x; asm volatile("" : "+v"(tid_));
    const int tid = tid_, wid = __builtin_amdgcn_readfirstlane(tid >> 6), lane = tid & 63, wr = wid >> 2, wc = wid & 3, fr = lane & 15, fq = lane >> 4;
    const int K = g.K, nt = K / BK;
    unsigned voffA[2], voffB[2];
#pragma unroll
    for (int i = 0; i < 2; ++i) { int R, C; stage_rc(tid * 16 + i * 8192, R, C); const int Rb = Epi::PERM ? ((R & ~31) + perm32(R & 31)) : R;
        voffA[i] = (unsigned)(R * K + C) * 2u; voffB[i] = (unsigned)(Rb * K + C) * 2u; }
    const size_t kstep = (size_t)(BK * 2);
    const size_t hstep = (size_t)HALF * K * 2;
    const size_t tstep = 2 * hstep;
    const unsigned ldsw = (unsigned)wid * 1024u;
    const int aoff = lds_byte(wr * 64 + fr, fq * 8), boff = lds_byte(wc * 32 + fr, fq * 8);
#define PG8_SA(b, h) (((b) * 2 + (h)) * HTB)
#define PG8_SB(b, h) ((4 + (b) * 2 + (h)) * HTB)
#define PG8_STAGE(bufoff, gbase, voff) do { _Pragma("unroll") for (int _i = 0; _i < 2; ++_i) \
        __builtin_amdgcn_global_load_lds((const unsigned*)((const char*)(gbase) + (voff)[_i]), (PG8_LAS unsigned*)(lds + (bufoff) + ldsw + _i * 8192), 16, 0, 0); } while (0)
#define PG8_LDA(dst, b, h) do { _Pragma("unroll") for (int m = 0; m < 4; ++m) _Pragma("unroll") for (int k = 0; k < 2; ++k) dst[m][k] = *(const PG8_LAS bf16x8*)(lds + PG8_SA(b, h) + aoff + m * 2048 + k * 1024); } while (0)
#define PG8_LDB(dst, b, h) do { _Pragma("unroll") for (int n = 0; n < 2; ++n) _Pragma("unroll") for (int k = 0; k < 2; ++k) dst[n][k] = *(const PG8_LAS bf16x8*)(lds + PG8_SB(b, h) + boff + n * 2048 + k * 1024); } while (0)
#define PG8_MMA(ai, bj, At, Bt) do { __builtin_amdgcn_s_setprio(1); _Pragma("unroll") for (int m = 0; m < 4; ++m) _Pragma("unroll") for (int n = 0; n < 2; ++n) _Pragma("unroll") for (int k = 0; k < 2; ++k) \
        acc[ai][bj][m][n] = __builtin_amdgcn_mfma_f32_16x16x32_bf16(Bt[n][k], At[m][k], acc[ai][bj][m][n], 0, 0, 0); __builtin_amdgcn_s_setprio(0); } while (0)
#define PG8_WAIT_V(n) asm volatile("s_waitcnt vmcnt(" #n ")" ::: "memory")
#define PG8_WAIT_L(n) asm volatile("s_waitcnt lgkmcnt(" #n ")" ::: "memory")
#define PG8_BAR __builtin_amdgcn_s_barrier()
#define PG8_SCHED __builtin_amdgcn_sched_barrier(0)
    Unit cur, nxt; int ui = 0;
    if (!S.next(0, cur)) return;
    f32x4 acc[2][2][4][2];
#pragma unroll
    for (int a = 0; a < 2; ++a)
#pragma unroll
        for (int b = 0; b < 2; ++b)
#pragma unroll
            for (int m = 0; m < 4; ++m)
#pragma unroll
                for (int n = 0; n < 2; ++n) acc[a][b][m][n] = (f32x4){0.f, 0.f, 0.f, 0.f};
    bf16x8 At[4][2], B0[2][2], B1[2][2];
    const char* cA = (const char*)g.A + (size_t)cur.pm * tstep; const char* cB = (const char*)g.Bt + S.boff(cur) + (size_t)cur.pn * tstep;
    S.a_ready(cur);
    if constexpr (SP2) {
        PG8_STAGE(PG8_SB(0, 0), cB, voffB); PG8_STAGE(PG8_SB(0, 1), cB + hstep, voffB); PG8_STAGE(PG8_SA(0, 0), cA, voffA); PG8_STAGE(PG8_SA(0, 1), cA + hstep, voffA);
        if (wr == 1) PG8_BAR;
        PG8_WAIT_V(2); PG8_BAR;
        PG8_STAGE(PG8_SB(1, 0), cB + kstep, voffB); PG8_STAGE(PG8_SA(1, 0), cA + kstep, voffA); PG8_STAGE(PG8_SB(1, 1), cB + hstep + kstep, voffB);
        PG8_WAIT_V(6); PG8_BAR;
    } else {
        PG8_STAGE(PG8_SB(0, 0), cB, voffB); PG8_STAGE(PG8_SA(0, 0), cA, voffA); PG8_STAGE(PG8_SB(0, 1), cB + hstep, voffB); PG8_STAGE(PG8_SA(0, 1), cA + hstep, voffA);
        if (wr == 1) PG8_BAR;
        PG8_WAIT_V(4); PG8_BAR;
        PG8_STAGE(PG8_SB(1, 0), cB + kstep, voffB); PG8_STAGE(PG8_SA(1, 0), cA + kstep, voffA); PG8_STAGE(PG8_SB(1, 1), cB + hstep + kstep, voffB);
        PG8_WAIT_V(6); PG8_BAR;
    }
    for (;;) {
        const bool has_next = S.next(ui + 1, nxt);
        const char* nA = has_next ? (const char*)g.A + (size_t)nxt.pm * tstep : cA; const char* nB = has_next ? (const char*)g.Bt + S.boff(nxt) + (size_t)nxt.pn * tstep : cB;
        for (int t = 0; t < nt; t += 2) {
            const bool last = (t == nt - 2);
            const char* a1 = cA + (size_t)(t + 1) * kstep;
            const char* a2 = last ? nA : cA + (size_t)(t + 2) * kstep; const char* b2 = last ? nB : cB + (size_t)(t + 2) * kstep;
            const char* a3 = a2 + kstep; const char* b3 = b2 + kstep;
            if (last && has_next) S.a_ready(nxt);
            if constexpr (SP2) {
            PG8_LDB(B0, 0, 0); PG8_LDB(B1, 0, 1); PG8_SCHED; PG8_LDA(At, 0, 0); PG8_STAGE(PG8_SA(1, 1), a1 + hstep, voffA);
            PG8_WAIT_V(8); PG8_WAIT_L(0); PG8_BAR; PG8_MMA(0, 0, At, B0); PG8_MMA(0, 1, At, B1); PG8_BAR; PG8_SCHED;
            PG8_LDA(At, 0, 1); PG8_STAGE(PG8_SB(0, 0), b2, voffB); PG8_STAGE(PG8_SB(0, 1), b2 + hstep, voffB); PG8_STAGE(PG8_SA(0, 0), a2, voffA);
            PG8_WAIT_V(8); PG8_WAIT_L(0); PG8_BAR; PG8_MMA(1, 0, At, B0); PG8_MMA(1, 1, At, B1); PG8_BAR; PG8_SCHED;
            PG8_LDB(B0, 1, 0); PG8_LDB(B1, 1, 1); PG8_SCHED; PG8_LDA(At, 1, 0); PG8_STAGE(PG8_SA(0, 1), a2 + hstep, voffA);
            PG8_WAIT_V(8); PG8_WAIT_L(0); PG8_BAR; PG8_MMA(0, 0, At, B0); PG8_MMA(0, 1, At, B1); PG8_BAR; PG8_SCHED;
            PG8_LDA(At, 1, 1); PG8_STAGE(PG8_SB(1, 0), b3, voffB); PG8_STAGE(PG8_SB(1, 1), b3 + hstep, voffB); PG8_STAGE(PG8_SA(1, 0), a3, voffA);
            PG8_WAIT_V(8); PG8_WAIT_L(0); PG8_BAR; PG8_MMA(1, 0, At, B0); PG8_MMA(1, 1, At, B1); PG8_BAR; PG8_SCHED;
            } else {
            PG8_LDB(B0, 0, 0); PG8_SCHED; PG8_LDA(At, 0, 0); PG8_STAGE(PG8_SA(1, 1), a1 + hstep, voffA);
            PG8_WAIT_L(8); PG8_BAR; PG8_WAIT_L(0); PG8_MMA(0, 0, At, B0); PG8_BAR; PG8_SCHED;
            PG8_LDB(B1, 0, 1); PG8_STAGE(PG8_SB(0, 0), b2, voffB);
            PG8_BAR; PG8_WAIT_L(0); PG8_MMA(0, 1, At, B1); PG8_BAR;
            PG8_LDA(At, 0, 1); PG8_STAGE(PG8_SA(0, 0), a2, voffA);
            PG8_BAR; PG8_WAIT_L(0); PG8_MMA(1, 0, At, B0); PG8_BAR; PG8_SCHED;
            PG8_STAGE(PG8_SB(0, 1), b2 + hstep, voffB);
            PG8_WAIT_V(6); PG8_BAR; PG8_MMA(1, 1, At, B1); PG8_BAR;
            PG8_LDB(B0, 1, 0); PG8_SCHED; PG8_LDA(At, 1, 0); PG8_STAGE(PG8_SA(0, 1), a2 + hstep, voffA);
            PG8_WAIT_L(8); PG8_BAR; PG8_WAIT_L(0); PG8_MMA(0, 0, At, B0); PG8_BAR; PG8_SCHED;
            PG8_LDB(B1, 1, 1); PG8_STAGE(PG8_SB(1, 0), b3, voffB);
            PG8_BAR; PG8_WAIT_L(0); PG8_MMA(0, 1, At, B1); PG8_BAR;
            PG8_LDA(At, 1, 1); PG8_STAGE(PG8_SA(1, 0), a3, voffA);
            PG8_BAR; PG8_WAIT_L(0); PG8_MMA(1, 0, At, B0); PG8_BAR; PG8_SCHED;
            PG8_STAGE(PG8_SB(1, 1), b3 + hstep, voffB);
            PG8_WAIT_V(6); PG8_BAR; PG8_MMA(1, 1, At, B1); PG8_BAR;
            }
        }
        if constexpr (ALIGN_EPI) { if (wr == 0) PG8_BAR; }
        if constexpr (!Epi::AFTER_DRAIN) { E(acc, cur, wr, wc, fr, fq); S.done(cur); }
        if (!has_next) break;
#pragma unroll
        for (int a = 0; a < 2; ++a)
#pragma unroll
            for (int b = 0; b < 2; ++b)
#pragma unroll
                for (int m = 0; m < 4; ++m)
#pragma unroll
                    for (int n = 0; n < 2; ++n) acc[a][b][m][n] = (f32x4){0.f, 0.f, 0.f, 0.f};
        cur = nxt; cA = nA; cB = nB; ++ui;
        if constexpr (ALIGN_EPI) { if (wr == 1) PG8_BAR; }
    }
    PG8_WAIT_V(0);
    if constexpr (!ALIGN_EPI) { if (wr == 0) PG8_BAR; }
    PG8_BAR;
    if constexpr (Epi::AFTER_DRAIN) { E.fused(acc, cur, wr, wc, fr, fq, lds, wid, lane); S.done(cur); }
#undef PG8_SA
#undef PG8_SB
#undef PG8_STAGE
#undef PG8_LDA
#undef PG8_LDB
#undef PG8_MMA
#undef PG8_WAIT_V
#undef PG8_WAIT_L
#undef PG8_BAR
#undef PG8_SCHED
}
}

#define GAS __attribute__((address_space(1)))
#define LAS __attribute__((address_space(3)))
typedef unsigned short bf16;
typedef unsigned v4u __attribute__((ext_vector_type(4)));
typedef float f32x4 __attribute__((ext_vector_type(4)));
typedef short bf16x8 __attribute__((ext_vector_type(8)));
typedef GAS unsigned gu32;
typedef GAS unsigned long long gu64;
#define RLX_AGENT __ATOMIC_RELAXED, __HIP_MEMORY_SCOPE_AGENT
#define LDS_WAIT() asm volatile("s_waitcnt lgkmcnt(0)" ::: "memory")
#define VM_WAIT() asm volatile("s_waitcnt vmcnt(0)" ::: "memory")
__device__ __forceinline__ unsigned long long rt() { return __builtin_amdgcn_s_memrealtime(); }
__device__ __forceinline__ unsigned f2bf(float f) { unsigned u = __builtin_bit_cast(unsigned, f); return (u + 0x7fffu + ((u >> 16) & 1u)) >> 16; }
__device__ __forceinline__ unsigned pk2(float lo, float hi) { return f2bf(lo) | (f2bf(hi) << 16); }
#define XB_TMO      128
#define XB_XCNT(j)  (256  + 64 * (j))
#define XB_XSUB(j)  (1280 + 64 * (j))
#define XB_XGEN(j)  (2304 + 64 * (j))
#define XB_TOP      3328
#define XB_TOPGEN   3392
#define XCD_BAR_WORDS 3456
#define XB_SPIN_CAP (1u << 22)

__device__ __forceinline__ unsigned xb_ld(unsigned* p)              { return __hip_atomic_load(p, __ATOMIC_RELAXED, __HIP_MEMORY_SCOPE_AGENT); }
__device__ __forceinline__ unsigned xb_add(unsigned* p, unsigned v) { return __hip_atomic_fetch_add(p, v, __ATOMIC_RELAXED, __HIP_MEMORY_SCOPE_AGENT); }
__device__ __forceinline__ unsigned xb_xcc_id() { return (unsigned)__builtin_amdgcn_s_getreg((3 << 11) | 20) & 0xFu; }
#define XB_SPIN(cond, bar) do { unsigned _sp = 0; while (cond) { __builtin_amdgcn_s_sleep(1); \
    if ((++_sp & 255u) == 0u) { if (xb_ld(&(bar)[XB_TMO])) break; if (_sp > XB_SPIN_CAP) { atomicAdd(&(bar)[XB_TMO], 1u); break; } } } } while (0)

struct XcdBarrier {
    unsigned* bar; unsigned x;
    volatile LAS unsigned* st;
};

__device__ __forceinline__ XcdBarrier xcd_barrier_post(unsigned* bar, volatile LAS unsigned* st) {
    XcdBarrier b; b.bar = bar; b.x = xb_xcc_id(); b.st = st;
    if (threadIdx.x == 0) (void)xb_add(&bar[XB_XCNT(b.x)], 1u);
    return b;
}
__device__ __forceinline__ void xcd_barrier_complete(unsigned* bar, unsigned x, unsigned& nloc, unsigned& nx) {
    const unsigned G = gridDim.x * gridDim.y * gridDim.z;
    unsigned sum, cnt, mine, sp = 0u;
    for (;;) {
        sum = 0u; cnt = 0u; mine = 0u;
#pragma unroll
        for (unsigned j = 0; j < 16; ++j) { const unsigned c = xb_ld(&bar[XB_XCNT(j)]); sum += c; cnt += (c > 0u) ? 1u : 0u; mine = (j == x) ? c : mine; }
        if (sum == G) break;
        __builtin_amdgcn_s_sleep(1);
        if ((++sp & 255u) == 0u) { if (xb_ld(&bar[XB_TMO])) break; if (sp > XB_SPIN_CAP) { atomicAdd(&bar[XB_TMO], 1u); break; } }
    }
    nloc = mine > 0u ? mine : 1u; nx = cnt > 0u ? cnt : 1u;
}

__device__ __forceinline__ void xcd_barrier(const XcdBarrier& b) {
    asm volatile("s_waitcnt vmcnt(0)" ::: "memory");
    __syncthreads();
    if (threadIdx.x == 0) {
        unsigned* bar = b.bar;
        __builtin_amdgcn_s_waitcnt(0);
        unsigned nloc = b.st[0], nx = b.st[1];
        if (nloc == 0u) { xcd_barrier_complete(bar, b.x, nloc, nx); b.st[0] = nloc; b.st[1] = nx; }
        const unsigned old = xb_add(&bar[XB_XSUB(b.x)], 1u);
        const unsigned gen = old / nloc;
        if (old + 1u == (gen + 1u) * nloc) {
            __builtin_amdgcn_fence(__ATOMIC_RELEASE, "agent");
            asm volatile("s_waitcnt vmcnt(0)" ::: "memory");
            const unsigned og = xb_add(&bar[XB_TOP], 1u);
            const unsigned tg = og / nx;
            if (og + 1u == (tg + 1u) * nx) xb_add(&bar[XB_TOPGEN], 1u);
            else XB_SPIN(xb_ld(&bar[XB_TOPGEN]) == tg, bar);
            __builtin_amdgcn_fence(__ATOMIC_ACQUIRE, "agent");
            xb_add(&bar[XB_XGEN(b.x)], 1u);
            asm volatile("s_waitcnt vmcnt(0)" ::: "memory");
        } else {
            XB_SPIN(xb_ld(&bar[XB_XGEN(b.x)]) == gen, bar);
            __builtin_amdgcn_fence(__ATOMIC_ACQUIRE, "agent");
            asm volatile("s_waitcnt vmcnt(0)" ::: "memory");
        }
    }
    __syncthreads();
}
constexpr int NWAVES = 8;
constexpr int BATCH = 4, SEQ = 8192, D = 1024, M = BATCH * SEQ, DEPTH = 4;
constexpr int MIXW = 768, MEMW = 256, HD = 64, NH = 12, NMH = 4, MEMLEN = 256, FF = 2816, NE = 8;
constexpr int NINA = 3 * MIXW + MEMW;
constexpr int NBLK = SEQ / 256;
constexpr int NKV = 2 * MIXW;
constexpr int NMKV = 2 * MEMW;
constexpr int XS_ROWS = 67584;
constexpr float LN_EPS = 1e-5f;
constexpr float ALPHA = 1.681792830507429f;
constexpr float QK_C2 = 0.125f * 1.4426950408889634f;

constexpr size_t MiB = 1u << 20;
constexpr size_t WS_CTL = 0, CTL_ZERO_BYTES = 1 * MiB;
constexpr size_t WS_COS = 1 * MiB, WS_SIN = 2 * MiB;
constexpr size_t WS_KMEAN = 3 * MiB;
constexpr size_t WS_TOPI = 4 * MiB, WS_TOPG = WS_TOPI + 256 * 1024, WS_POS = WS_TOPG + 256 * 1024;
constexpr size_t WS_MEMB = 5 * MiB;
constexpr size_t WS_MEMKV = 7 * MiB;
constexpr size_t WS_WINA = 12 * MiB;
constexpr size_t WS_WQB = 22 * MiB;
constexpr size_t WS_WKV = 26 * MiB;
constexpr size_t WS_WMKV = 29 * MiB;
constexpr size_t WS_WO = 33 * MiB;
constexpr size_t WS_WGUD = 41 * MiB;
constexpr size_t WS_WDD = 63 * MiB;
constexpr size_t WS_WGUM = 74 * MiB;
constexpr size_t WS_WDM = 250 * MiB;
constexpr size_t WS_XB = 338 * MiB;
constexpr size_t WS_KS = 402 * MiB, WS_VS = 450 * MiB;
constexpr size_t WS_XS = 498 * MiB;
constexpr size_t WS_BIG = 630 * MiB;
constexpr size_t WS_PROJ = WS_BIG, WS_MIX = WS_BIG + 160 * MiB;
constexpr size_t WS_END = 993 * MiB;
static_assert(WS_XS + (size_t)XS_ROWS * D * 2 <= WS_BIG && WS_BIG + (size_t)XS_ROWS * FF * 2 <= WS_END && WS_MIX + (size_t)M * D * 2 <= WS_END, "ws map");
static_assert(WS_WDM + (size_t)16 * D * FF * 2 <= WS_XB && WS_WGUM + (size_t)16 * 2 * FF * D * 2 <= WS_WDM && WS_WDD + (size_t)2 * D * FF * 2 <= WS_WGUM && WS_WGUD + (size_t)2 * 2 * FF * D * 2 <= WS_WDD, "ws map weights");
constexpr int CW_BAR = 4096;
constexpr int CW_CNT = 8192, CW_CUR = 8192 + 1024;
__host__ __device__ constexpr int cw_cnt(int ls, int e) { return CW_CNT + (ls * 8 + e) * 64; }
__host__ __device__ constexpr int cw_cur(int ls, int e) { return CW_CUR + (ls * 8 + e) * 64; }

constexpr int RING_OFF = 0, RING_BYTES = 131072;
constexpr int LDSCTL_OFF = RING_BYTES, MISC_OFF = LDSCTL_OFF + 320;
constexpr int LDS_BYTES = 147456;

struct Args { const float* in[18]; float* out; unsigned char* ws; double invf[8]; };
struct Frame {
    LAS unsigned char* lds; volatile LAS unsigned* MISC; unsigned* ctl;
    int tid, lane, wave, vcu, G, gw, NGW;
    unsigned char* ws; float* X; bf16* XB;
};
__device__ __forceinline__ float wave_sum(float v) {
#pragma unroll
    for (int o = 1; o < 64; o <<= 1) v += __shfl_xor(v, o);
    return v;
}
__device__ __forceinline__ float bflo(unsigned w) { return __uint_as_float(w << 16); }
__device__ __forceinline__ float bfhi(unsigned w) { return __uint_as_float(w & 0xffff0000u); }
__device__ __forceinline__ void unpack8(const v4u w, float (&f)[8]) { f[0] = bflo(w.x); f[1] = bfhi(w.x); f[2] = bflo(w.y); f[3] = bfhi(w.y); f[4] = bflo(w.z); f[5] = bfhi(w.z); f[6] = bflo(w.w); f[7] = bfhi(w.w); }
__device__ __forceinline__ v4u pack8(const float (&f)[8]) { v4u w; w.x = pk2(f[0], f[1]); w.y = pk2(f[2], f[3]); w.z = pk2(f[4], f[5]); w.w = pk2(f[6], f[7]); return w; }

template <int MODE>
__device__ __forceinline__ void p0_transpose_item(const float* W, int K, int N, bf16* WT, LAS float* scr, int item, int lane) {
    const int nblk = N / 32, kb = item / nblk, nb = item % nblk, k0 = 64 * kb, n0 = 32 * nb;
    int d0 = n0;
    if (MODE == 1) { const int f = n0 < FF ? n0 : n0 - FF; d0 = (f >> 7) * 256 + (f & 127) + (n0 < FF ? 0 : 128); }
#pragma unroll 8
    for (int i = 0; i < 32; ++i) { const int kk = 2 * i + (lane >> 5); scr[kk * 33 + (lane & 31)] = W[(size_t)(k0 + kk) * N + n0 + (lane & 31)]; }
    LDS_WAIT(); asm volatile("" ::: "memory");
    const int c = lane & 7;
#pragma unroll
    for (int j = 0; j < 4; ++j) { const int n = (lane >> 3) + 8 * j; const LAS float* s = scr + (8 * c) * 33 + n;
        v4u o; o.x = pk2(s[0 * 33], s[1 * 33]); o.y = pk2(s[2 * 33], s[3 * 33]); o.z = pk2(s[4 * 33], s[5 * 33]); o.w = pk2(s[6 * 33], s[7 * 33]);
        *(v4u*)(WT + (size_t)(d0 + n) * K + k0 + 8 * c) = o; }
    LDS_WAIT(); asm volatile("" ::: "memory");
}
__device__ __forceinline__ void sincos_f64(double a, float& s, float& c) {
    const double kd = __builtin_rint(a * 0.63661977236758134308);
    double r = __builtin_fma(-kd, 1.57079632673412561417e+00, a); r = __builtin_fma(-kd, 6.07710050650619224932e-11, r);
    const int q = ((int)kd) & 3; const double z = r * r;
    const double sp = r + r * z * (-1.66666666666666324348e-01 + z * (8.33333333332248946124e-03 + z * (-1.98412698298579493134e-04 + z * (2.75573137070700676789e-06 + z * (-2.50507602534068634195e-08 + z * 1.58969099521155010221e-10)))));
    const double cp = 1.0 - 0.5 * z + z * z * (4.16666666666666019037e-02 + z * (-1.38888888888741095749e-03 + z * (2.48015872894767294178e-05 + z * (-2.75573143513906633035e-07 + z * (2.08757232129817482790e-09 + z * -1.13596475577881948265e-11)))));
    const float sf = (float)sp, cf = (float)cp;
    s = (q == 0) ? sf : (q == 1) ? cf : (q == 2) ? -sf : -cf;
    c = (q == 0) ? cf : (q == 1) ? -sf : (q == 2) ? -cf : sf;
}
__device__ __forceinline__ void p0_prologue(Frame& F, const Args& args) {
    LAS float* scr = (LAS float*)(F.lds + RING_OFF + F.wave * 16384);
    const float* const* in = args.in;
    bf16* ws16 = (bf16*)F.ws;
#define TGROUP(src, nmat, KK, NN, dstoff, MODE) { constexpr int I_ = ((KK) / 64) * ((NN) / 32); if (r < (nmat) * I_) { const int mi = r / I_, it2 = r % I_; \
        p0_transpose_item<MODE>((src) + (size_t)mi * (KK) * (NN), (KK), (NN), (bf16*)(F.ws + (dstoff)) + (size_t)mi * (NN) * (KK), scr, it2, F.lane); continue; } r -= (nmat) * I_; }
    constexpr int NITEMS = 2 * 16 * 80 + 2 * 16 * 32 + 16 * 48 + 4 * 16 * 16 + 4 * 16 * 32 + 2 * 16 * 176 + 2 * 44 * 32 + 16 * 16 * 176 + 16 * 44 * 32;
    for (int it = F.gw; it < NITEMS; it += F.NGW) {
        int r = it;
        TGROUP(in[3], 2, D, NINA, WS_WINA, 0)
        TGROUP(in[5], 2, D, D, WS_WQB, 0)
        TGROUP(in[6], 1, D, NKV, WS_WKV, 0)
        TGROUP(in[7], 4, D, NMKV, WS_WMKV, 0)
        TGROUP(in[8], 4, D, D, WS_WO, 0)
        TGROUP(in[13], 2, D, 2 * FF, WS_WGUD, 1)
        TGROUP(in[14], 2, FF, D, WS_WDD, 0)
        TGROUP(in[16], 16, D, 2 * FF, WS_WGUM, 1)
        TGROUP(in[17], 16, FF, D, WS_WDM, 0)
    }
#undef TGROUP
    (void)ws16;
    const int gt = F.gw * 64 + F.lane, NT = F.NGW * 64;
    { const f32x4* x4 = (const f32x4*)in[0]; v4u* o = (v4u*)F.XB;
      for (int i = gt; i < M * D / 8; i += NT) { const f32x4 a = x4[2 * i], b = x4[2 * i + 1]; v4u w; w.x = pk2(a.x, a.y); w.y = pk2(a.z, a.w); w.z = pk2(b.x, b.y); w.w = pk2(b.z, b.w); o[i] = w; } }
    { const f32x4* x4 = (const f32x4*)in[1]; v4u* o = (v4u*)(F.ws + WS_MEMB);
      for (int i = gt; i < BATCH * MEMLEN * D / 8; i += NT) { const f32x4 a = x4[2 * i], b = x4[2 * i + 1]; v4u w; w.x = pk2(a.x, a.y); w.y = pk2(a.z, a.w); w.z = pk2(b.x, b.y); w.w = pk2(b.z, b.w); o[i] = w; } }
    { const int* pos = (const int*)in[2]; float* cs = (float*)(F.ws + WS_COS); float* sn = (float*)(F.ws + WS_SIN);
      for (int i = gt; i < M * 8; i += NT) { const double a = (double)pos[i >> 3] * args.invf[i & 7]; float s, c; sincos_f64(a, s, c); cs[i] = c; sn[i] = s; } }
}
template <bool ROUTER, bool COMBINE>
__device__ __forceinline__ void ln_phase(Frame& F, const float* gain, const float* bias, const float* wrt, int ls) {
    f32x4 gv[4], bv[4];
#pragma unroll
    for (int j = 0; j < 4; ++j) { gv[j] = ((const f32x4*)gain)[64 * j + F.lane]; bv[j] = ((const f32x4*)bias)[64 * j + F.lane]; }
    const int* POS = (const int*)(F.ws + WS_POS); const float* TOPG = (const float*)(F.ws + WS_TOPG); const bf16* Y = (const bf16*)(F.ws + WS_XS);
    int* TOPI = (int*)(F.ws + WS_TOPI); float* TOPGw = (float*)(F.ws + WS_TOPG);
    int c0 = 0, c1 = 0, c2 = 0, c3 = 0, c4 = 0, c5 = 0, c6 = 0, c7 = 0;
    for (int row = F.gw; row < M; row += F.NGW) {
        f32x4* xr = (f32x4*)(F.X + (size_t)row * D) + F.lane;
        f32x4 v[4]; float s = 0.f;
#pragma unroll
        for (int j = 0; j < 4; ++j) v[j] = xr[64 * j];
        if (COMBINE) {
            const int p0 = POS[2 * row], p1 = POS[2 * row + 1]; const float g0 = TOPG[2 * row], g1 = TOPG[2 * row + 1];
            const uint2* y0 = (const uint2*)(Y + (size_t)p0 * D) + F.lane; const uint2* y1 = (const uint2*)(Y + (size_t)p1 * D) + F.lane;
#pragma unroll
            for (int j = 0; j < 4; ++j) { const uint2 a = y0[64 * j], b = y1[64 * j];
                v[j].x = v[j].x * ALPHA + g0 * bflo(a.x) + g1 * bflo(b.x); v[j].y = v[j].y * ALPHA + g0 * bfhi(a.x) + g1 * bfhi(b.x);
                v[j].z = v[j].z * ALPHA + g0 * bflo(a.y) + g1 * bflo(b.y); v[j].w = v[j].w * ALPHA + g0 * bfhi(a.y) + g1 * bfhi(b.y); }
        }
#pragma unroll
        for (int j = 0; j < 4; ++j) s += (v[j].x + v[j].y) + (v[j].z + v[j].w);
        const float mean = wave_sum(s) * (1.f / D); float s2 = 0.f;
#pragma unroll
        for (int j = 0; j < 4; ++j) { v[j] = v[j] - mean; s2 += (v[j].x * v[j].x + v[j].y * v[j].y) + (v[j].z * v[j].z + v[j].w * v[j].w); }
        const float rstd = 1.f / sqrtf(wave_sum(s2) * (1.f / D) + LN_EPS);
        unsigned long long* o8 = (unsigned long long*)(F.XB + (size_t)row * D) + F.lane;
#pragma unroll
        for (int j = 0; j < 4; ++j) { v[j] = v[j] * rstd * gv[j] + bv[j]; xr[64 * j] = v[j];
            o8[64 * j] = (unsigned long long)pk2(v[j].x, v[j].y) | ((unsigned long long)pk2(v[j].z, v[j].w) << 32); }
        if (ROUTER) {
            float lg[8];
#pragma unroll
            for (int e = 0; e < 8; ++e) lg[e] = 0.f;
#pragma unroll
            for (int j = 0; j < 4; ++j)
#pragma unroll
                for (int c = 0; c < 4; ++c) { const int k = 4 * (64 * j + F.lane) + c; const f32x4 w0 = ((const f32x4*)wrt)[2 * k], w1 = ((const f32x4*)wrt)[2 * k + 1]; const float xv = v[j][c];
                    lg[0] += xv * w0.x; lg[1] += xv * w0.y; lg[2] += xv * w0.z; lg[3] += xv * w0.w; lg[4] += xv * w1.x; lg[5] += xv * w1.y; lg[6] += xv * w1.z; lg[7] += xv * w1.w; }
#pragma unroll
            for (int e = 0; e < 8; ++e) lg[e] = wave_sum(lg[e]);
            int i1 = 0; float l1 = lg[0];
#pragma unroll
            for (int e = 1; e < 8; ++e) if (lg[e] > l1) { l1 = lg[e]; i1 = e; }
            int i2 = -1; float l2 = -INFINITY;
#pragma unroll
            for (int e = 0; e < 8; ++e) if (e != i1 && lg[e] > l2) { l2 = lg[e]; i2 = e; }
            const float ex = __expf(l2 - l1); const float g1 = 1.f / (1.f + ex), g2 = ex * g1;
            if (F.lane == 0) { TOPI[2 * row] = i1; TOPI[2 * row + 1] = i2; TOPGw[2 * row] = g1; TOPGw[2 * row + 1] = g2; }
            c0 += (i1 == 0) + (i2 == 0); c1 += (i1 == 1) + (i2 == 1); c2 += (i1 == 2) + (i2 == 2); c3 += (i1 == 3) + (i2 == 3);
            c4 += (i1 == 4) + (i2 == 4); c5 += (i1 == 5) + (i2 == 5); c6 += (i1 == 6) + (i2 == 6); c7 += (i1 == 7) + (i2 == 7);
        }
    }
    if (ROUTER && F.lane == 0) {
        __hip_atomic_fetch_add(F.ctl + cw_cnt(ls, 0), (unsigned)c0, RLX_AGENT); __hip_atomic_fetch_add(F.ctl + cw_cnt(ls, 1), (unsigned)c1, RLX_AGENT);
        __hip_atomic_fetch_add(F.ctl + cw_cnt(ls, 2), (unsigned)c2, RLX_AGENT); __hip_atomic_fetch_add(F.ctl + cw_cnt(ls, 3), (unsigned)c3, RLX_AGENT);
        __hip_atomic_fetch_add(F.ctl + cw_cnt(ls, 4), (unsigned)c4, RLX_AGENT); __hip_atomic_fetch_add(F.ctl + cw_cnt(ls, 5), (unsigned)c5, RLX_AGENT);
        __hip_atomic_fetch_add(F.ctl + cw_cnt(ls, 6), (unsigned)c6, RLX_AGENT); __hip_atomic_fetch_add(F.ctl + cw_cnt(ls, 7), (unsigned)c7, RLX_AGENT);
    }
}
struct Segs { int ps[9]; };
__device__ __forceinline__ void load_segs(Frame& F, int ls, Segs& sg) {
    sg.ps[0] = 0;
#pragma unroll
    for (int e = 0; e < 8; ++e) { const unsigned c = __builtin_amdgcn_readfirstlane(__hip_atomic_load(F.ctl + cw_cnt(ls, e), RLX_AGENT)); sg.ps[e + 1] = sg.ps[e] + (int)((c + 255u) >> 8); }
}
__device__ __forceinline__ void scatter_phase(Frame& F, int ls) {
    Segs sg; load_segs(F, ls, sg);
    const int* TOPI = (const int*)(F.ws + WS_TOPI); int* POS = (int*)(F.ws + WS_POS); bf16* XS = (bf16*)(F.ws + WS_XS);
    for (int item = F.gw; item < M / 64; item += F.NGW) {
        const int row = item * 64 + F.lane; int posk[2];
#pragma unroll
        for (int k = 0; k < 2; ++k) {
            const int e = TOPI[2 * row + k]; int pos = 0;
#pragma unroll
            for (int ee = 0; ee < 8; ++ee) {
                const unsigned long long mask = __ballot(e == ee);
                if (mask) { unsigned base = 0; if (F.lane == 0) base = __hip_atomic_fetch_add(F.ctl + cw_cur(ls, ee), (unsigned)__popcll(mask), RLX_AGENT);
                    base = __builtin_amdgcn_readfirstlane(base);
                    if (e == ee) pos = sg.ps[ee] * 256 + (int)base + (int)__popcll(mask & ((1ull << F.lane) - 1ull)); }
            }
            POS[2 * row + k] = pos; posk[k] = pos;
        }
        for (int i = 0; i < 64; ++i) {
            const v4u* src = (const v4u*)(F.XB + (size_t)(item * 64 + i) * D); const v4u a = src[F.lane], b = src[F.lane + 64];
#pragma unroll
            for (int k = 0; k < 2; ++k) { const int p = __shfl(posk[k], i); v4u* dst = (v4u*)(XS + (size_t)p * D); dst[F.lane] = a; dst[F.lane + 64] = b; }
        }
    }
}
__device__ __forceinline__ void ropek_phase(Frame& F) {
    bf16* KS = (bf16*)(F.ws + WS_KS); const float* COS = (const float*)(F.ws + WS_COS); const float* SIN = (const float*)(F.ws + WS_SIN); float* KMEAN = (float*)(F.ws + WS_KMEAN);
    const int lr = F.lane >> 3, ch = F.lane & 7;
    for (int unit = F.gw; unit < BATCH * NH * NBLK; unit += F.NGW) {
        const int b = unit / (NH * NBLK), h = (unit / NBLK) % NH, n = unit % NBLK;
        float sum[8];
#pragma unroll
        for (int i = 0; i < 8; ++i) sum[i] = 0.f;
        for (int it = 0; it < 32; ++it) {
            const int row = b * SEQ + n * 256 + it * 8 + lr; v4u* p = (v4u*)(KS + (size_t)row * MIXW + h * HD + ch * 8);
            float f[8], pf[8]; unpack8(*p, f);
#pragma unroll
            for (int i = 0; i < 8; ++i) pf[i] = __shfl_xor(f[i], 1);
            if (ch < 2) {
                const f32x4 ca = ((const f32x4*)COS)[2 * row], cb = ((const f32x4*)COS)[2 * row + 1], sa = ((const f32x4*)SIN)[2 * row], sb = ((const f32x4*)SIN)[2 * row + 1];
                const float cs[8] = {ca.x, ca.y, ca.z, ca.w, cb.x, cb.y, cb.z, cb.w}, sn[8] = {sa.x, sa.y, sa.z, sa.w, sb.x, sb.y, sb.z, sb.w};
#pragma unroll
                for (int i = 0; i < 8; ++i) f[i] = (ch == 0) ? f[i] * cs[i] - pf[i] * sn[i] : f[i] * cs[i] + pf[i] * sn[i];
                *p = pack8(f);
            }
#pragma unroll
            for (int i = 0; i < 8; ++i) sum[i] += f[i];
        }
#pragma unroll
        for (int i = 0; i < 8; ++i) { float s = sum[i]; s += __shfl_xor(s, 8); s += __shfl_xor(s, 16); s += __shfl_xor(s, 32); sum[i] = s * (1.f / 256.f); }
        if (F.lane < 8) { float* o = KMEAN + (size_t)unit * HD + ch * 8;
#pragma unroll
            for (int i = 0; i < 8; ++i) o[i] = sum[i]; }
    }
}
__device__ __forceinline__ void attend_keys(const bf16* Kp, const bf16* Vp, int nkeys, int stride, const float (&q)[64], float sc, float& m, float& l, float (&o)[64]) {
    for (int j = 0; j < nkeys; ++j) {
        const v4u* kr = (const v4u*)(Kp + (size_t)j * stride); float s = 0.f;
#pragma unroll
        for (int c = 0; c < 8; ++c) { const v4u w = kr[c];
            s += q[8 * c] * bflo(w.x) + q[8 * c + 1] * bfhi(w.x) + q[8 * c + 2] * bflo(w.y) + q[8 * c + 3] * bfhi(w.y) + q[8 * c + 4] * bflo(w.z) + q[8 * c + 5] * bfhi(w.z) + q[8 * c + 6] * bflo(w.w) + q[8 * c + 7] * bfhi(w.w); }
        s *= sc;
        if (s > m) { const float f = __builtin_amdgcn_exp2f(m - s); l *= f;
#pragma unroll
            for (int d = 0; d < 64; ++d) o[d] *= f;
            m = s; }
        const float p = __builtin_amdgcn_exp2f(s - m); l += p;
        const v4u* vr = (const v4u*)(Vp + (size_t)j * stride);
#pragma unroll
        for (int c = 0; c < 8; ++c) { const v4u w = vr[c];
            o[8 * c] += p * bflo(w.x); o[8 * c + 1] += p * bfhi(w.x); o[8 * c + 2] += p * bflo(w.y); o[8 * c + 3] += p * bfhi(w.y); o[8 * c + 4] += p * bflo(w.z); o[8 * c + 5] += p * bfhi(w.z); o[8 * c + 6] += p * bflo(w.w); o[8 * c + 7] += p * bfhi(w.w); }
    }
}
__device__ __forceinline__ void load_q64(const bf16* qp, float (&q)[64]) {
#pragma unroll
    for (int c = 0; c < 8; ++c) { const v4u w = ((const v4u*)qp)[c]; q[8 * c] = bflo(w.x); q[8 * c + 1] = bfhi(w.x); q[8 * c + 2] = bflo(w.y); q[8 * c + 3] = bfhi(w.y); q[8 * c + 4] = bflo(w.z); q[8 * c + 5] = bfhi(w.z); q[8 * c + 6] = bflo(w.w); q[8 * c + 7] = bfhi(w.w); }
}
__device__ __forceinline__ void store_o64(bf16* op, const float (&o)[64], float inv) {
#pragma unroll
    for (int c = 0; c < 8; ++c) { v4u w; w.x = pk2(o[8 * c] * inv, o[8 * c + 1] * inv); w.y = pk2(o[8 * c + 2] * inv, o[8 * c + 3] * inv); w.z = pk2(o[8 * c + 4] * inv, o[8 * c + 5] * inv); w.w = pk2(o[8 * c + 6] * inv, o[8 * c + 7] * inv); ((v4u*)op)[c] = w; }
}
__device__ __forceinline__ void memattn_phase(Frame& F, const bf16* qbase, int ldq, int layer) {
    const bf16* MKV = (const bf16*)(F.ws + WS_MEMKV); bf16* MIX = (bf16*)(F.ws + WS_MIX);
    for (int item = F.gw; item < BATCH * NMH * (SEQ / 64); item += F.NGW) {
        const int b = item / (NMH * (SEQ / 64)), h = (item / (SEQ / 64)) % NMH, g = item % (SEQ / 64);
        const int row = b * SEQ + g * 64 + F.lane;
        float q[64], o[64]; load_q64(qbase + (size_t)row * ldq + h * HD, q);
#pragma unroll
        for (int d = 0; d < 64; ++d) o[d] = 0.f;
        float m = -INFINITY, l = 0.f;
        const bf16* Kp = MKV + (size_t)(b * MEMLEN) * (DEPTH * NMKV) + layer * NMKV + h * HD;
        attend_keys(Kp, Kp + MEMW, MEMLEN, DEPTH * NMKV, q, QK_C2, m, l, o);
        store_o64(MIX + (size_t)row * D + MIXW + h * HD, o, 1.f / l);
    }
}
__device__ __forceinline__ void conv_phase(Frame& F, const float* cw) {
    const bf16* PROJ = (const bf16*)(F.ws + WS_PROJ); bf16* MIX = (bf16*)(F.ws + WS_MIX);
    const int gt = F.gw * 64 + F.lane, NT = F.NGW * 64;
    for (int item = gt; item < (M / 32) * (MIXW / 8); item += NT) {
        const int chunk = item / (MIXW / 8), cg = item % (MIXW / 8), r0 = chunk * 32, c0 = cg * 8;
        float w0[8], w1[8], w2[8], p2[8], p1[8];
#pragma unroll
        for (int i = 0; i < 8; ++i) { w0[i] = cw[c0 + i]; w1[i] = cw[MIXW + c0 + i]; w2[i] = cw[2 * MIXW + c0 + i]; p2[i] = 0.f; p1[i] = 0.f; }
        if ((r0 & (SEQ - 1)) != 0) {
            float a[8], b[8];
            unpack8(*(const v4u*)(PROJ + (size_t)(r0 - 2) * NINA + MIXW + c0), a); unpack8(*(const v4u*)(PROJ + (size_t)(r0 - 2) * NINA + 2 * MIXW + c0), b);
#pragma unroll
            for (int i = 0; i < 8; ++i) p2[i] = a[i] * b[i];
            unpack8(*(const v4u*)(PROJ + (size_t)(r0 - 1) * NINA + MIXW + c0), a); unpack8(*(const v4u*)(PROJ + (size_t)(r0 - 1) * NINA + 2 * MIXW + c0), b);
#pragma unroll
            for (int i = 0; i < 8; ++i) p1[i] = a[i] * b[i];
        }
        for (int rr = 0; rr < 32; ++rr) {
            const size_t row = (size_t)(r0 + rr); float ub[8], uc[8], uh[8], o[8];
            unpack8(*(const v4u*)(PROJ + row * NINA + c0), ub); unpack8(*(const v4u*)(PROJ + row * NINA + MIXW + c0), uc); unpack8(*(const v4u*)(PROJ + row * NINA + 2 * MIXW + c0), uh);
#pragma unroll
            for (int i = 0; i < 8; ++i) { const float cu = uc[i] * uh[i]; o[i] = ub[i] * (w0[i] * p2[i] + w1[i] * p1[i] + w2[i] * cu); p2[i] = p1[i]; p1[i] = cu; }
            *(v4u*)(MIX + row * D + c0) = pack8(o);
        }
    }
}
__device__ __forceinline__ void moba_phase(Frame& F) {
    const bf16* Q = (const bf16*)(F.ws + WS_PROJ); const bf16* KS = (const bf16*)(F.ws + WS_KS); const bf16* VS = (const bf16*)(F.ws + WS_VS);
    const float* COS = (const float*)(F.ws + WS_COS); const float* SIN = (const float*)(F.ws + WS_SIN); const float* KMEAN = (const float*)(F.ws + WS_KMEAN); bf16* MIX = (bf16*)(F.ws + WS_MIX);
    for (int item = F.gw; item < BATCH * NH * (SEQ / 64); item += F.NGW) {
        const int b = item / (NH * (SEQ / 64)), h = (item / (SEQ / 64)) % NH, g = item % (SEQ / 64);
        const int t = g * 64 + F.lane, row = b * SEQ + t, own = g >> 2;
        float q[64], o[64]; load_q64(Q + (size_t)row * D + h * HD, q);
        { const f32x4 ca = ((const f32x4*)COS)[2 * row], cb = ((const f32x4*)COS)[2 * row + 1], sa = ((const f32x4*)SIN)[2 * row], sb = ((const f32x4*)SIN)[2 * row + 1];
          const float cs[8] = {ca.x, ca.y, ca.z, ca.w, cb.x, cb.y, cb.z, cb.w}, sn[8] = {sa.x, sa.y, sa.z, sa.w, sb.x, sb.y, sb.z, sb.w};
#pragma unroll
          for (int i = 0; i < 8; ++i) { const float t1 = q[i], t2 = q[8 + i]; q[i] = t1 * cs[i] - t2 * sn[i]; q[8 + i] = t2 * cs[i] + t1 * sn[i]; } }
        float v0 = -INFINITY, v1 = -INFINITY, v2 = -INFINITY; int i0 = 0, i1 = 0, i2 = 0;
        for (int n = 0; n < own; ++n) {
            const f32x4* km = (const f32x4*)(KMEAN + ((size_t)(b * NH + h) * NBLK + n) * HD); float gsc = 0.f;
#pragma unroll
            for (int c = 0; c < 16; ++c) { const f32x4 w = km[c]; gsc += q[4 * c] * w.x + q[4 * c + 1] * w.y + q[4 * c + 2] * w.z + q[4 * c + 3] * w.w; }
            if (gsc > v0) { v2 = v1; i2 = i1; v1 = v0; i1 = i0; v0 = gsc; i0 = n; }
            else if (gsc > v1) { v2 = v1; i2 = i1; v1 = gsc; i1 = n; }
            else if (gsc > v2) { v2 = gsc; i2 = n; }
        }
#pragma unroll
        for (int d = 0; d < 64; ++d) o[d] = 0.f;
        float m = -INFINITY, l = 0.f;
        const int nsel = own < 3 ? own : 3;
        for (int s = 0; s < nsel; ++s) {
            const int blk = (s == 0) ? i0 : (s == 1) ? i1 : i2; const size_t off = (size_t)(b * SEQ + blk * 256) * MIXW + h * HD;
            attend_keys(KS + off, VS + off, 256, MIXW, q, QK_C2, m, l, o);
        }
        { const size_t off = (size_t)(b * SEQ + own * 256) * MIXW + h * HD; attend_keys(KS + off, VS + off, (t & 255) + 1, MIXW, q, QK_C2, m, l, o); }
        store_o64(MIX + (size_t)row * D + h * HD, o, 1.f / l);
    }
}
template <int layer>
__device__ __forceinline__ void layer_body(Frame& F, const Args& args, const XcdBarrier& bar) {
#define GRID_BAR() xcd_barrier(bar)
    unsigned char* ws = args.ws;
    const pg8::bf16_t* XBc = (const pg8::bf16_t*)(ws + WS_XB);
    pg8::bf16_t* PROJ = (pg8::bf16_t*)(ws + WS_PROJ); pg8::bf16_t* MIXp = (pg8::bf16_t*)(ws + WS_MIX); pg8::bf16_t* HB = (pg8::bf16_t*)(ws + WS_BIG); pg8::bf16_t* XSp = (pg8::bf16_t*)(ws + WS_XS);
    const int cid = (int)blockIdx.x;
        constexpr bool isA = layer < 2, isMoe = (layer & 1) != 0; constexpr int ls = layer >> 1;
        {
            const int N1 = isA ? NINA : D;
            const pg8::bf16_t* Bt = isA ? (const pg8::bf16_t*)(ws + WS_WINA) + (size_t)layer * NINA * D : (const pg8::bf16_t*)(ws + WS_WQB) + (size_t)(layer - 2) * D * D;
            pg8::Gemm g{XBc, Bt, M, N1, D}; pg8::PanelOrder S; S.init(M / 256, N1 / 256, F.G, cid);
            pg8::EpiBf16 E{PROJ, N1, 0, 0};
            pg8::gemm_phase<pg8::EpiBf16, pg8::PanelOrder, true, true>(F.lds + RING_OFF, g, S, E);
        }
        if constexpr (layer == 0) {
            pg8::Gemm g{(const pg8::bf16_t*)(ws + WS_MEMB), (const pg8::bf16_t*)(ws + WS_WMKV), BATCH * MEMLEN, DEPTH * NMKV, D}; pg8::PanelOrder S; S.init(BATCH * MEMLEN / 256, DEPTH * NMKV / 256, F.G, cid);
            pg8::EpiBf16 E{(pg8::bf16_t*)(ws + WS_MEMKV), DEPTH * NMKV, 0, 0};
            pg8::gemm_phase<pg8::EpiBf16, pg8::PanelOrder, true, true>(F.lds + RING_OFF, g, S, E);
        }
        GRID_BAR();
        if constexpr (isA) { conv_phase(F, args.in[4] + (size_t)layer * 3 * MIXW); memattn_phase(F, (const bf16*)(ws + WS_PROJ) + 3 * MIXW, NINA, layer); }
        else     { moba_phase(F); memattn_phase(F, (const bf16*)(ws + WS_PROJ) + MIXW, D, layer); }
        GRID_BAR();
        {
            pg8::Gemm g{MIXp, (const pg8::bf16_t*)(ws + WS_WO) + (size_t)layer * D * D, M, D, D}; pg8::PanelOrder S; S.init(M / 256, D / 256, F.G, cid);
            pg8::EpiRes E{layer == 0 ? args.in[0] : (const float*)F.X, F.X, D, ALPHA};
            pg8::gemm_phase<pg8::EpiRes, pg8::PanelOrder, true, true>(F.lds + RING_OFF, g, S, E);
        }
        GRID_BAR();
        if constexpr (isMoe) ln_phase<true, false>(F, args.in[9] + layer * D, args.in[10] + layer * D, args.in[15] + (size_t)ls * D * NE, ls);
        else       ln_phase<false, false>(F, args.in[9] + layer * D, args.in[10] + layer * D, nullptr, 0);
        GRID_BAR();
        if constexpr (isMoe) { scatter_phase(F, ls); GRID_BAR(); }
        {
            pg8::PanelOrder S; Segs sg;
            if constexpr (isMoe) { load_segs(F, ls, sg); S.init(sg.ps[8], 2 * FF / 256, F.G, cid); S.ps1 = sg.ps[1]; S.ps2 = sg.ps[2]; S.ps3 = sg.ps[3]; S.ps4 = sg.ps[4]; S.ps5 = sg.ps[5]; S.ps6 = sg.ps[6]; S.ps7 = sg.ps[7]; S.estride = (size_t)2 * FF * D * 2; }
            else S.init(M / 256, 2 * FF / 256, F.G, cid);
            const pg8::bf16_t* Bt = isMoe ? (const pg8::bf16_t*)(ws + WS_WGUM) + (size_t)ls * NE * 2 * FF * D : (const pg8::bf16_t*)(ws + WS_WGUD) + (size_t)ls * 2 * FF * D;
            pg8::Gemm g{isMoe ? (const pg8::bf16_t*)XSp : XBc, Bt, M, 2 * FF, D};
            pg8::EpiGlu E{HB, FF};
            pg8::gemm_phase<pg8::EpiGlu, pg8::PanelOrder, true, true>(F.lds + RING_OFF, g, S, E);
        }
        GRID_BAR();
        if constexpr (isMoe) {
            pg8::PanelOrder S; Segs sg; load_segs(F, ls, sg); S.init(sg.ps[8], D / 256, F.G, cid);
            S.ps1 = sg.ps[1]; S.ps2 = sg.ps[2]; S.ps3 = sg.ps[3]; S.ps4 = sg.ps[4]; S.ps5 = sg.ps[5]; S.ps6 = sg.ps[6]; S.ps7 = sg.ps[7]; S.estride = (size_t)D * FF * 2;
            pg8::Gemm g{HB, (const pg8::bf16_t*)(ws + WS_WDM) + (size_t)ls * NE * D * FF, M, D, FF};
            pg8::EpiBf16 E{XSp, D, 0, 0};
            pg8::gemm_phase<pg8::EpiBf16, pg8::PanelOrder, true, true>(F.lds + RING_OFF, g, S, E);
        } else {
            pg8::PanelOrder S; S.init(M / 256, D / 256, F.G, cid);
            pg8::Gemm g{HB, (const pg8::bf16_t*)(ws + WS_WDD) + (size_t)ls * D * FF, M, D, FF};
            pg8::EpiRes E{(const float*)F.X, F.X, D, ALPHA};
            pg8::gemm_phase<pg8::EpiRes, pg8::PanelOrder, true, true>(F.lds + RING_OFF, g, S, E);
        }
        GRID_BAR();
        if constexpr (isMoe) ln_phase<false, true>(F, args.in[11] + layer * D, args.in[12] + layer * D, nullptr, 0);
        else       ln_phase<false, false>(F, args.in[11] + layer * D, args.in[12] + layer * D, nullptr, 0);
        if constexpr (layer == DEPTH - 1) return;
        GRID_BAR();
        if constexpr (layer == 1) {
            pg8::Gemm g{XBc, (const pg8::bf16_t*)(ws + WS_WKV), M, NKV, D}; pg8::PanelOrder S; S.init(M / 256, NKV / 256, F.G, cid);
            pg8::EpiBf16 E{(pg8::bf16_t*)(ws + WS_KS), MIXW, MIXW, (size_t)(WS_VS - WS_KS) / 2};
            pg8::gemm_phase<pg8::EpiBf16, pg8::PanelOrder, true, true>(F.lds + RING_OFF, g, S, E);
            GRID_BAR();
            ropek_phase(F);
            GRID_BAR();
        }

}
#undef GRID_BAR
__global__ void __launch_bounds__(NWAVES * 64, 2) mega_fwd(Args args) {
    extern __shared__ __attribute__((aligned(16))) unsigned char lds[];
    Frame F;
    F.lds = (LAS unsigned char*)lds; F.MISC = (volatile LAS unsigned*)(F.lds + MISC_OFF);
    F.tid = threadIdx.x; F.lane = F.tid & 63; F.wave = __builtin_amdgcn_readfirstlane(F.tid >> 6);
    F.G = gridDim.x; { const int bx = blockIdx.x; F.vcu = (F.G % 8 == 0) ? (bx % 8) * (F.G / 8) + bx / 8 : bx; }
    F.gw = F.vcu * NWAVES + F.wave; F.NGW = F.G * NWAVES;
    F.ws = args.ws; F.ctl = (unsigned*)(args.ws + WS_CTL); F.X = args.out; F.XB = (bf16*)(args.ws + WS_XB);
    for (int u = F.tid; u < (LDS_BYTES - LDSCTL_OFF) / 4; u += NWAVES * 64) ((LAS unsigned*)(F.lds + LDSCTL_OFF))[u] = 0u;
    __syncthreads();
    XcdBarrier bar = xcd_barrier_post(F.ctl + CW_BAR, F.MISC + 8);
#define GRID_BAR() xcd_barrier(bar)

    p0_prologue(F, args);
    GRID_BAR();

    layer_body<0>(F, args, bar);
    layer_body<1>(F, args, bar);
    layer_body<2>(F, args, bar);
    layer_body<3>(F, args, bar);
#undef GRID_BAR
}

extern "C" void kernel_launch(void* const* d_in, const int* in_sizes, int n_in, void* d_out, int out_size, void* d_ws, size_t ws_size, hipStream_t stream) {
    static int grid = 0;
    if (grid == 0) {
        if (n_in != 18 || in_sizes[0] != M * D || out_size != M * D || ws_size < WS_END) { fprintf(stderr, "kernel_launch: unexpected shapes / workspace (n_in %d, in0 %d, out %d, ws %zu, need %zu); nothing launched\n", n_in, n_in > 0 ? in_sizes[0] : -1, out_size, ws_size, (size_t)WS_END); grid = -1; return; }
        int dev = 0, cus = 0, per_cu = 0;
        if (hipGetDevice(&dev) != hipSuccess || hipDeviceGetAttribute(&cus, hipDeviceAttributeMultiprocessorCount, dev) != hipSuccess) { grid = -1; return; }
        if (hipFuncSetAttribute((const void*)mega_fwd, hipFuncAttributeMaxDynamicSharedMemorySize, LDS_BYTES) != hipSuccess) { fprintf(stderr, "kernel_launch: hipFuncSetAttribute failed\n"); grid = -1; return; }
        if (hipOccupancyMaxActiveBlocksPerMultiprocessor(&per_cu, (const void*)mega_fwd, NWAVES * 64, LDS_BYTES) != hipSuccess || per_cu < 1) { fprintf(stderr, "kernel_launch: occupancy query reports %d workgroups per CU\n", per_cu); }
        (void)hipGetLastError();
        grid = cus;
    }
    if (grid < 0) return;
    if (hipMemsetAsync((char*)d_ws + WS_CTL, 0, CTL_ZERO_BYTES, stream) != hipSuccess) return;
    Args a{};
    for (int i = 0; i < 18; ++i) a.in[i] = (const float*)d_in[i];
    a.out = (float*)d_out; a.ws = (unsigned char*)d_ws;
    for (int i = 0; i < 8; ++i) a.invf[i] = pow(500000.0, -(double)i / 8.0);
    hipLaunchKernelGGL(mega_fwd, dim3(grid), dim3(NWAVES * 64), LDS_BYTES, stream, a);
}
```

```cpp
#include <hip/hip_runtime.h>
#include <cstdio>
#include <cstdint>
#include <cmath>
#include <hip/hip_bf16.h>
__device__ __forceinline__ int sx_lane_() { int l = (int)__builtin_amdgcn_mbcnt_hi(~0u, __builtin_amdgcn_mbcnt_lo(~0u, 0u)); asm volatile("" : "+v"(l)); return l; }
__device__ __forceinline__ int sx_i_(int v, int m) { return __builtin_amdgcn_ds_bpermute((sx_lane_() ^ m) << 2, v); }
__device__ __forceinline__ float my_shfl_xor(float v, int m) { return __builtin_bit_cast(float, sx_i_(__builtin_bit_cast(int, v), m)); }
__device__ __forceinline__ int my_shfl_xor(int v, int m) { return sx_i_(v, m); }
__device__ __forceinline__ unsigned my_shfl_xor(unsigned v, int m) { return (unsigned)sx_i_((int)v, m); }
__device__ __forceinline__ int my_shfl(int v, int src) { return __builtin_amdgcn_ds_bpermute(src << 2, v); }
#define __shfl_xor(v, m) my_shfl_xor((v), (m))
#define __shfl(v, s) my_shfl((v), (s))
namespace pg8 {
#define PG8_LAS __attribute__((address_space(3)))
typedef unsigned short bf16_t;
typedef short bf16x8 __attribute__((ext_vector_type(8)));
typedef float f32x4 __attribute__((ext_vector_type(4)));
typedef unsigned u32x4 __attribute__((ext_vector_type(4)));
constexpr int BM = 256, BK = 64, HALF = 128, HTB = HALF * BK * 2  , STAGE_BYTES = 8 * HTB, NXCD = 8, WGM = 8;

__host__ __device__ __forceinline__ int lds_byte(int r, int c) { const int st = (r >> 4) * 2 + (c >> 5), rr = r & 15, cc = c & 31, ob = rr * 64 + cc * 2; return st * 1024 + (ob ^ (((ob >> 9) & 1) << 5)); }
__host__ __device__ __forceinline__ void stage_rc(int b, int& R, int& C) { const int st = b / 1024, sb = b % 1024, swz = sb ^ (((sb >> 9) & 1) << 5); R = (st >> 1) * 16 + swz / 64; C = (st & 1) * 32 + (swz % 64) / 2; }
__host__ __device__ __forceinline__ int perm32(int rho) { const int n = rho >> 4, i = rho & 15; return 8 * (i >> 2) + 4 * n + (i & 3); }

struct Unit { int pm, pn, part; };
struct Gemm { const bf16_t* A; const bf16_t* Bt; int M, N, K; int ld; size_t kpart; };

struct PanelOrder {
    int nM, nN, nwg, G, c; int ps1, ps2, ps3, ps4, ps5, ps6, ps7; size_t estride; int pm0, nNr, wgm;
    __device__ __forceinline__ void init(int nM_, int nN_, int G_, int c_) { nM = nM_; nN = nN_; nwg = nM * nN; G = G_; c = c_; ps1 = ps2 = ps3 = ps4 = ps5 = ps6 = ps7 = 0x7fffffff; estride = 0; pm0 = 0; nNr = nN_; wgm = 4; }
    __device__ __forceinline__ bool next(int i, Unit& u) const {
        const long L = (long)i * G + c; if (L >= nwg) return false;
        int wgid = (int)L; { const int q = nwg / NXCD, r = nwg % NXCD, xcd = wgid % NXCD, off = wgid / NXCD; wgid = (xcd < r ? xcd * (q + 1) : r * (q + 1) + (xcd - r) * q) + off; }
        const int nig = wgm * nN, gid = wgid / nig, fm = gid * wgm, gsz = (nM - fm) < wgm ? (nM - fm) : wgm;
        u.pm = pm0 + fm + ((wgid % nig) % gsz); const int pnv = (wgid % nig) / gsz; u.part = pnv / nNr; u.pn = pnv - u.part * nNr; return true;
    }
    __device__ __forceinline__ size_t boff(const Unit& u) const {
        const int e = (int)(u.pm >= ps1) + (int)(u.pm >= ps2) + (int)(u.pm >= ps3) + (int)(u.pm >= ps4) + (int)(u.pm >= ps5) + (int)(u.pm >= ps6) + (int)(u.pm >= ps7);
        return (size_t)e * estride;
    }
    __device__ __forceinline__ void a_ready(const Unit&) const {}
    __device__ __forceinline__ void done(const Unit&) const {}
};
__device__ __forceinline__ unsigned cvt_pk_bf16(float lo, float hi) { unsigned r; asm volatile("v_cvt_pk_bf16_f32 %0, %1, %2" : "=v"(r) : "v"(lo), "v"(hi)); return r; }
typedef float f32x2 __attribute__((ext_vector_type(2)));
typedef float f32x2 __attribute__((ext_vector_type(2)));
struct EpiBf16 {
    static constexpr bool PERM = true, AFTER_DRAIN = false, AUX = false;
    bf16_t* O; int ldc; int split_cols; size_t split_stride; int row_off; size_t part_stride;
    __device__ __forceinline__ void operator()(const f32x4 (&acc)[2][2][4][2], const Unit& u, int wr, int wc, int fr, int fq) const {
        const int row0 = u.pm * BM + wr * 64 + fr - row_off; int colt = u.pn * BM; bf16_t* base = O + (size_t)u.part * part_stride;
        if (split_cols) { const int t = colt / split_cols; base += (size_t)t * split_stride; colt -= t * split_cols; }
        const int col0 = colt + wc * 32 + 8 * fq;
#pragma unroll
        for (int ai = 0; ai < 2; ++ai)
#pragma unroll
            for (int m = 0; m < 4; ++m) { bf16_t* rowp = base + (size_t)(row0 + ai * HALF + m * 16) * ldc + col0;
#pragma unroll
                for (int bj = 0; bj < 2; ++bj) { const f32x4 v0 = acc[ai][bj][m][0], v1 = acc[ai][bj][m][1];
                    u32x4 w; w.x = cvt_pk_bf16(v0[0], v0[1]); w.y = cvt_pk_bf16(v0[2], v0[3]); w.z = cvt_pk_bf16(v1[0], v1[1]); w.w = cvt_pk_bf16(v1[2], v1[3]);
                    *(u32x4*)(rowp + bj * HALF) = w; } }
    }
};
__device__ __forceinline__ float silu_mul(float g, float u) { const float e = __builtin_amdgcn_exp2f(g * -1.4426950408889634f); return g * __builtin_amdgcn_rcpf(1.0f + e) * u; }
struct EpiGlu {
    static constexpr bool PERM = true, AFTER_DRAIN = false, AUX = false;
    bf16_t* O; int ldc;
    __device__ __forceinline__ void operator()(const f32x4 (&acc)[2][2][4][2], const Unit& u, int wr, int wc, int fr, int fq) const {
        const int row0 = u.pm * BM + wr * 64 + fr; const int col0 = u.pn * HALF + wc * 32 + 8 * fq;
#pragma unroll
        for (int ai = 0; ai < 2; ++ai)
#pragma unroll
            for (int m = 0; m < 4; ++m) { bf16_t* rowp = O + (size_t)(row0 + ai * HALF + m * 16) * ldc + col0;
                const f32x4 g0 = acc[ai][0][m][0], g1 = acc[ai][0][m][1], u0 = acc[ai][1][m][0], u1 = acc[ai][1][m][1];
                u32x4 w; w.x = cvt_pk_bf16(silu_mul(g0[0], u0[0]), silu_mul(g0[1], u0[1])); w.y = cvt_pk_bf16(silu_mul(g0[2], u0[2]), silu_mul(g0[3], u0[3]));
                w.z = cvt_pk_bf16(silu_mul(g1[0], u1[0]), silu_mul(g1[1], u1[1])); w.w = cvt_pk_bf16(silu_mul(g1[2], u1[2]), silu_mul(g1[3], u1[3]));
                *(u32x4*)rowp = w; }
    }
};
struct EpiGluQ {
    static constexpr bool PERM = true, AFTER_DRAIN = false, AUX = true;
    bf16_t* O; int ldc; const float* rs; const unsigned* csu; int ps1, ps2, ps3, ps4, ps5, ps6, ps7; int cs_estride;
    __device__ __forceinline__ int expert(const Unit& u) const { return (int)(u.pm >= ps1) + (int)(u.pm >= ps2) + (int)(u.pm >= ps3) + (int)(u.pm >= ps4) + (int)(u.pm >= ps5) + (int)(u.pm >= ps6) + (int)(u.pm >= ps7); }
    __device__ __forceinline__ void stage_aux(const Unit& u, PG8_LAS unsigned char* aux, int lane) const {
        __builtin_amdgcn_global_load_lds((const unsigned*)(rs + (size_t)u.pm * BM) + lane * 4, (PG8_LAS unsigned*)aux, 16, 0, 0);
        __builtin_amdgcn_global_load_lds(csu + (size_t)expert(u) * cs_estride + u.pn * BM + lane * 4, (PG8_LAS unsigned*)(aux + 1024), 16, 0, 0);
    }
    __device__ __forceinline__ void operator()(const f32x4 (&acc)[2][2][4][2], const Unit& u, int wr, int wc, int fr, int fq, const PG8_LAS unsigned char* aux) const {
        const int row0 = u.pm * BM + wr * 64 + fr; const int col0 = u.pn * HALF + wc * 32 + 8 * fq;
        const PG8_LAS float* ar = (const PG8_LAS float*)aux + wr * 64 + fr; const PG8_LAS float* ac = (const PG8_LAS float*)(aux + 1024) + wc * 32 + 8 * fq;
        float rsv[8];
#pragma unroll
        for (int i = 0; i < 8; ++i) rsv[i] = ar[(i >> 2) * HALF + (i & 3) * 16];
        f32x2 kg[4], kc[4];
#pragma unroll
        for (int i = 0; i < 4; ++i) { const f32x2 g = {ac[2 * i], ac[2 * i + 1]}, uu = {ac[HALF + 2 * i], ac[HALF + 2 * i + 1]}; kg[i] = g * (-1.4426950408889634f / 127.0f); kc[i] = g * uu * (1.0f / 16129.0f); }
#pragma unroll
        for (int ai = 0; ai < 2; ++ai)
#pragma unroll
            for (int m = 0; m < 4; ++m) { const int row = row0 + ai * HALF + m * 16; bf16_t* rowp = O + (size_t)row * ldc + col0; const float r = rsv[ai * 4 + m]; const f32x2 rr = {r, r};
                f32x2 x[4], y[4], e[4];
#pragma unroll
                for (int p = 0; p < 4; ++p) { const int n = p >> 1, j = (p & 1) * 2;
                    x[p] = (f32x2){(float)__float_as_int(acc[ai][0][m][n][j]), (float)__float_as_int(acc[ai][0][m][n][j + 1])} * rr;
                    y[p] = (f32x2){(float)__float_as_int(acc[ai][1][m][n][j]), (float)__float_as_int(acc[ai][1][m][n][j + 1])} * rr; }
#pragma unroll
                for (int p = 0; p < 4; ++p) e[p] = x[p] * kg[p];
#pragma unroll
                for (int p = 0; p < 4; ++p) { e[p].x = __builtin_amdgcn_exp2f(e[p].x); e[p].y = __builtin_amdgcn_exp2f(e[p].y); }
#pragma unroll
                for (int p = 0; p < 4; ++p) { e[p] = e[p] + (f32x2){1.0f, 1.0f}; x[p] = x[p] * y[p]; }
#pragma unroll
                for (int p = 0; p < 4; ++p) { e[p].x = __builtin_amdgcn_rcpf(e[p].x); e[p].y = __builtin_amdgcn_rcpf(e[p].y); x[p] = x[p] * kc[p]; }
#pragma unroll
                for (int p = 0; p < 4; ++p) x[p] = x[p] * e[p];
                u32x4 w; w.x = cvt_pk_bf16(x[0].x, x[0].y); w.y = cvt_pk_bf16(x[1].x, x[1].y); w.z = cvt_pk_bf16(x[2].x, x[2].y); w.w = cvt_pk_bf16(x[3].x, x[3].y);
                *(u32x4*)rowp = w; }
    }
};
struct EpiRes {
    static constexpr bool PERM = true, AFTER_DRAIN = false, AUX = false;
    bf16_t* X; int ldc; float alpha;
    __device__ __forceinline__ void operator()(const f32x4 (&acc)[2][2][4][2], const Unit& u, int wr, int wc, int fr, int fq) const {
        const int row0 = u.pm * BM + wr * 64 + fr; const int col0 = u.pn * BM + wc * 32 + 8 * fq;
        bf16_t* const base = X + (size_t)row0 * ldc + col0;
        u32x4 b[2][4][2];
#pragma unroll
        for (int ai = 0; ai < 2; ++ai)
#pragma unroll
            for (int m = 0; m < 4; ++m)
#pragma unroll
                for (int bj = 0; bj < 2; ++bj) b[ai][m][bj] = *(const u32x4*)(base + (size_t)(ai * HALF + m * 16) * ldc + bj * HALF);
#pragma unroll
        for (int ai = 0; ai < 2; ++ai)
#pragma unroll
            for (int m = 0; m < 4; ++m)
#pragma unroll
                for (int bj = 0; bj < 2; ++bj) { const u32x4 r = b[ai][m][bj]; const f32x4 v0 = acc[ai][bj][m][0], v1 = acc[ai][bj][m][1];
                    u32x4 w;
                    w.x = cvt_pk_bf16(__uint_as_float(r.x << 16) * alpha + v0[0], __uint_as_float(r.x & 0xffff0000u) * alpha + v0[1]);
                    w.y = cvt_pk_bf16(__uint_as_float(r.y << 16) * alpha + v0[2], __uint_as_float(r.y & 0xffff0000u) * alpha + v0[3]);
                    w.z = cvt_pk_bf16(__uint_as_float(r.z << 16) * alpha + v1[0], __uint_as_float(r.z & 0xffff0000u) * alpha + v1[1]);
                    w.w = cvt_pk_bf16(__uint_as_float(r.w << 16) * alpha + v1[2], __uint_as_float(r.w & 0xffff0000u) * alpha + v1[3]);
                    *(u32x4*)(base + (size_t)(ai * HALF + m * 16) * ldc + bj * HALF) = w; }
    }
};

__device__ __forceinline__ float epi_xor16(float v, bool odd_row) { auto r = __builtin_amdgcn_permlane16_swap(__float_as_uint(v), __float_as_uint(v), false, false); return __uint_as_float(odd_row ? r[0] : r[1]); }
template <int CTRL> __device__ __forceinline__ float epi_dpp(float v) { return __builtin_bit_cast(float, __builtin_amdgcn_update_dpp(0, __builtin_bit_cast(int, v), CTRL, 0xf, 0xf, true)); }
__device__ __forceinline__ float epi_rowsum16(float v) { v += epi_dpp<0xB1>(v); v += epi_dpp<0x4E>(v); v += epi_dpp<0x141>(v); v += epi_dpp<0x140>(v); return v; }
struct EpiKV {
    static constexpr bool PERM = true, AFTER_DRAIN = false, AUX = false;
    bf16_t* KSo; bf16_t* VSo; const float* cs; const float* sn; float* kmp;
    __device__ __forceinline__ void operator()(const f32x4 (&acc)[2][2][4][2], const Unit& u, int wr, int wc, int fr, int fq) const {
        const bool isK = u.pn < 3; const int colt = (isK ? u.pn : u.pn - 3) * BM; bf16_t* base = isK ? KSo : VSo;
        const int row0 = u.pm * BM + wr * 64 + fr; const int col0 = colt + wc * 32 + 8 * fq; const bool first = isK && ((wc & 1) == 0);
        f32x4 cs0[2], cs1[2];
#pragma unroll
        for (int bj = 0; bj < 2; ++bj) { cs0[bj] = (f32x4){0.f, 0.f, 0.f, 0.f}; cs1[bj] = cs0[bj]; }
#pragma unroll
        for (int ai = 0; ai < 2; ++ai)
#pragma unroll
            for (int m = 0; m < 4; ++m) { const int row = row0 + ai * HALF + m * 16; bf16_t* rowp = base + (size_t)row * 768 + col0;
                f32x4 c_lo = {1.f, 1.f, 1.f, 1.f}, c_hi = c_lo, s_lo = {0.f, 0.f, 0.f, 0.f}, s_hi = s_lo;
                if (first) { c_lo = ((const f32x4*)cs)[2 * row]; c_hi = ((const f32x4*)cs)[2 * row + 1]; s_lo = ((const f32x4*)sn)[2 * row]; s_hi = ((const f32x4*)sn)[2 * row + 1]; }
#pragma unroll
                for (int bj = 0; bj < 2; ++bj) { f32x4 v0 = acc[ai][bj][m][0], v1 = acc[ai][bj][m][1];
                    if (first) {
                        f32x4 p0, p1;
#pragma unroll
                        for (int j = 0; j < 4; ++j) { p0[j] = epi_xor16(v0[j], (fq & 1) != 0); p1[j] = epi_xor16(v1[j], (fq & 1) != 0); }
                        if (fq == 0) { v0 = v0 * c_lo - p0 * s_lo; v1 = v1 * c_hi - p1 * s_hi; }
                        else if (fq == 1) { v0 = v0 * c_lo + p0 * s_lo; v1 = v1 * c_hi + p1 * s_hi; }
                    }
                    cs0[bj] += v0; cs1[bj] += v1;
                    u32x4 w; w.x = cvt_pk_bf16(v0[0], v0[1]); w.y = cvt_pk_bf16(v0[2], v0[3]); w.z = cvt_pk_bf16(v1[0], v1[1]); w.w = cvt_pk_bf16(v1[2], v1[3]);
                    *(u32x4*)(rowp + bj * HALF) = w; } }
        if (isK) {
#pragma unroll
            for (int bj = 0; bj < 2; ++bj)
#pragma unroll
                for (int j = 0; j < 4; ++j) { float a = cs0[bj][j], b = cs1[bj][j];
                    a = epi_rowsum16(a); b = epi_rowsum16(b);
                    cs0[bj][j] = a; cs1[bj][j] = b; }
            if (fr == 0) { const int bq = u.pm / 32, n = u.pm % 32;
#pragma unroll
                for (int bj = 0; bj < 2; ++bj) { const int col = colt + bj * HALF + wc * 32 + 8 * fq, head = col >> 6, d = col & 63;
                    float* o = kmp + (((size_t)wr * 48 + bq * 12 + head) * 32 + n) * 64 + d; *(f32x4*)o = cs0[bj]; *(f32x4*)(o + 4) = cs1[bj]; } }
        }
    }
};
struct EpiQ8 {
    static constexpr bool PERM = true, AFTER_DRAIN = false, AUX = true;
    bf16_t* O; int ldc; int scale_from; float c2; const float* rs; const unsigned* csu;
    __device__ __forceinline__ void stage_aux(const Unit& u, PG8_LAS unsigned char* aux, int lane) const {
        __builtin_amdgcn_global_load_lds((const unsigned*)(rs + (size_t)u.pm * BM) + lane * 4, (PG8_LAS unsigned*)aux, 16, 0, 0);
        __builtin_amdgcn_global_load_lds(csu + u.pn * BM + lane * 4, (PG8_LAS unsigned*)(aux + 1024), 16, 0, 0);
    }
    __device__ __forceinline__ void operator()(const f32x4 (&acc)[2][2][4][2], const Unit& u, int wr, int wc, int fr, int fq, const PG8_LAS unsigned char* aux) const {
        const int row0 = u.pm * BM + wr * 64 + fr; const int col0 = u.pn * BM + wc * 32 + 8 * fq;
        const PG8_LAS float* ar = (const PG8_LAS float*)aux + wr * 64 + fr; const PG8_LAS float* ac = (const PG8_LAS float*)(aux + 1024) + wc * 32 + 8 * fq;
        const float sc = (u.pn >= scale_from ? c2 : 1.f) * (1.0f / 127.0f);
        float rsv[8];
#pragma unroll
        for (int i = 0; i < 8; ++i) rsv[i] = ar[(i >> 2) * HALF + (i & 3) * 16];
        f32x2 kq[2][4];
#pragma unroll
        for (int bj = 0; bj < 2; ++bj)
#pragma unroll
            for (int i = 0; i < 4; ++i) kq[bj][i] = (f32x2){ac[bj * HALF + 2 * i], ac[bj * HALF + 2 * i + 1]} * sc;
#pragma unroll
        for (int ai = 0; ai < 2; ++ai)
#pragma unroll
            for (int m = 0; m < 4; ++m) { const int row = row0 + ai * HALF + m * 16; bf16_t* rowp = O + (size_t)row * ldc + col0; const float r = rsv[ai * 4 + m]; const f32x2 rr = {r, r};
#pragma unroll
                for (int bj = 0; bj < 2; ++bj) { f32x2 x[4];
#pragma unroll
                    for (int p = 0; p < 4; ++p) { const int n = p >> 1, j = (p & 1) * 2;
                        x[p] = (f32x2){(float)__float_as_int(acc[ai][bj][m][n][j]), (float)__float_as_int(acc[ai][bj][m][n][j + 1])} * rr * kq[bj][p]; }
                    u32x4 w; w.x = cvt_pk_bf16(x[0].x, x[0].y); w.y = cvt_pk_bf16(x[1].x, x[1].y); w.z = cvt_pk_bf16(x[2].x, x[2].y); w.w = cvt_pk_bf16(x[3].x, x[3].y);
                    *(u32x4*)(rowp + bj * HALF) = w; } }
    }
};
template <bool Q8> struct EpiQ {
    static constexpr bool PERM = true, AFTER_DRAIN = false, AUX = false;
    bf16_t* O; int ldc; int rope_tiles; int scale_from; const float* cs; const float* sn; float c2; const float* rs; const unsigned* csu;
    __device__ __forceinline__ void operator()(const f32x4 (&acc)[2][2][4][2], const Unit& u, int wr, int wc, int fr, int fq) const {
        const int row0 = u.pm * BM + wr * 64 + fr; const int col0 = u.pn * BM + wc * 32 + 8 * fq;
        const bool rope = u.pn < rope_tiles; const float sc = (rope || u.pn >= scale_from) ? c2 : 1.f; const bool first = rope && ((wc & 1) == 0);
        float cq[2][8];
        if (Q8) {
#pragma unroll
            for (int bj = 0; bj < 2; ++bj)
#pragma unroll
                for (int i = 0; i < 8; ++i) cq[bj][i] = __uint_as_float(csu[col0 + bj * HALF + i]) * (1.0f / 127.0f); }
#pragma unroll
        for (int ai = 0; ai < 2; ++ai)
#pragma unroll
            for (int m = 0; m < 4; ++m) { const int row = row0 + ai * HALF + m * 16; bf16_t* rowp = O + (size_t)row * ldc + col0;
                f32x4 c_lo = {1.f, 1.f, 1.f, 1.f}, c_hi = c_lo, s_lo = {0.f, 0.f, 0.f, 0.f}, s_hi = s_lo;
                if (first) { c_lo = ((const f32x4*)cs)[2 * row]; c_hi = ((const f32x4*)cs)[2 * row + 1]; s_lo = ((const f32x4*)sn)[2 * row]; s_hi = ((const f32x4*)sn)[2 * row + 1]; }
#pragma unroll
                for (int bj = 0; bj < 2; ++bj) { f32x4 v0 = acc[ai][bj][m][0], v1 = acc[ai][bj][m][1];
                    if (Q8) { const float r = rs[row];
#pragma unroll
                        for (int j = 0; j < 4; ++j) { v0[j] = (float)__float_as_int(v0[j]) * (r * cq[bj][j]); v1[j] = (float)__float_as_int(v1[j]) * (r * cq[bj][4 + j]); } }
                    if (first) {
                        f32x4 p0, p1;
#pragma unroll
                        for (int j = 0; j < 4; ++j) { p0[j] = epi_xor16(v0[j], (fq & 1) != 0); p1[j] = epi_xor16(v1[j], (fq & 1) != 0); }
                        if (fq == 0) { v0 = v0 * c_lo - p0 * s_lo; v1 = v1 * c_hi - p1 * s_hi; }
                        else if (fq == 1) { v0 = v0 * c_lo + p0 * s_lo; v1 = v1 * c_hi + p1 * s_hi; }
                    }
                    v0 = v0 * sc; v1 = v1 * sc;
                    u32x4 w; w.x = cvt_pk_bf16(v0[0], v0[1]); w.y = cvt_pk_bf16(v0[2], v0[3]); w.z = cvt_pk_bf16(v1[0], v1[1]); w.w = cvt_pk_bf16(v1[2], v1[3]);
                    *(u32x4*)(rowp + bj * HALF) = w; } }
    }
};

typedef int pg8_v4i __attribute__((ext_vector_type(4))); typedef int pg8_v8i __attribute__((ext_vector_type(8)));
__device__ __forceinline__ pg8_v8i pg8_cat(bf16x8 a, bf16x8 b) { const pg8_v4i x = __builtin_bit_cast(pg8_v4i, a), y = __builtin_bit_cast(pg8_v4i, b); return __builtin_shufflevector(x, y, 0, 1, 2, 3, 4, 5, 6, 7); }
template <class Epi, class Sched, bool ALIGN_EPI = false, bool SP2 = false, bool I8 = false>
__device__ __forceinline__ void gemm_phase(PG8_LAS unsigned char* lds, const Gemm g, const Sched& S, const Epi& E) {
    int tid_ = threadIdx.x; asm volatile("" : "+v"(tid_));
    const int tid = tid_, wid = __builtin_amdgcn_readfirstlane(tid >> 6), lane = tid & 63, wr = wid >> 2, wc = wid & 3, fr = lane & 15, fq = lane >> 4;
    const int K = g.ld, nt = g.K / BK;
    unsigned voffA[2], voffB[2];
#pragma unroll
    for (int i = 0; i < 2; ++i) { int R, C; stage_rc(tid * 16 + i * 8192, R, C); const int Rb = Epi::PERM ? ((R & ~31) + perm32(R & 31)) : R;
        voffA[i] = (unsigned)(R * K + C) * 2u; voffB[i] = (unsigned)(Rb * K + C) * 2u; }
    const size_t kstep = (size_t)(BK * 2);
    const size_t hstep = (size_t)HALF * K * 2;
    const size_t tstep = 2 * hstep;
    const unsigned ldsw = (unsigned)wid * 1024u;
    const int aoff = lds_byte(wr * 64 + fr, fq * 8), boff = lds_byte(wc * 32 + fr, fq * 8);
#define PG8_SA(b, h) (((b) * 2 + (h)) * HTB)
#define PG8_SB(b, h) ((4 + (b) * 2 + (h)) * HTB)
#define PG8_STAGE(bufoff, gbase, voff) do { _Pragma("unroll") for (int _i = 0; _i < 2; ++_i) \
        __builtin_amdgcn_global_load_lds((const unsigned*)((const char*)(gbase) + (voff)[_i]), (PG8_LAS unsigned*)(lds + (bufoff) + ldsw + _i * 8192), 16, 0, 0); } while (0)
#define PG8_LD32(base_) __builtin_shufflevector(*(const PG8_LAS pg8_v4i*)(lds + (base_)), *(const PG8_LAS pg8_v4i*)(lds + (base_) + 1024), 0, 1, 2, 3, 4, 5, 6, 7)
#define PG8_LDA(dst, b, h) do { _Pragma("unroll") for (int m = 0; m < 4; ++m) dst[m] = PG8_LD32(PG8_SA(b, h) + aoff + m * 2048); } while (0)
#define PG8_LDB(dst, b, h) do { _Pragma("unroll") for (int n = 0; n < 2; ++n) dst[n] = PG8_LD32(PG8_SB(b, h) + boff + n * 2048); } while (0)
#define PG8_LO(v) __builtin_bit_cast(bf16x8, __builtin_shufflevector(v, v, 0, 1, 2, 3))
#define PG8_HI(v) __builtin_bit_cast(bf16x8, __builtin_shufflevector(v, v, 4, 5, 6, 7))
#define PG8_MMA(ai, bj, At, Bt) do { __builtin_amdgcn_s_setprio(1); \
        if constexpr (I8) { _Pragma("unroll") for (int m = 0; m < 4; ++m) _Pragma("unroll") for (int n = 0; n < 2; ++n) { pg8_v4i c_ = __builtin_bit_cast(pg8_v4i, acc[ai][bj][m][n]); \
            c_ = __builtin_amdgcn_mfma_i32_16x16x64_i8(__builtin_shufflevector(Bt[n], Bt[n], 0, 1, 2, 3), __builtin_shufflevector(At[m], At[m], 0, 1, 2, 3), c_, 0, 0, 0); \
            c_ = __builtin_amdgcn_mfma_i32_16x16x64_i8(__builtin_shufflevector(Bt[n], Bt[n], 4, 5, 6, 7), __builtin_shufflevector(At[m], At[m], 4, 5, 6, 7), c_, 0, 0, 0); \
            acc[ai][bj][m][n] = __builtin_bit_cast(f32x4, c_); } } \
        else { _Pragma("unroll") for (int m = 0; m < 4; ++m) _Pragma("unroll") for (int n = 0; n < 2; ++n) { \
            acc[ai][bj][m][n] = __builtin_amdgcn_mfma_f32_16x16x32_bf16(PG8_LO(Bt[n]), PG8_LO(At[m]), acc[ai][bj][m][n], 0, 0, 0); \
            acc[ai][bj][m][n] = __builtin_amdgcn_mfma_f32_16x16x32_bf16(PG8_HI(Bt[n]), PG8_HI(At[m]), acc[ai][bj][m][n], 0, 0, 0); } } \
        __builtin_amdgcn_s_setprio(0); } while (0)
#define PG8_WAIT_V(n) asm volatile("s_waitcnt vmcnt(" #n ")" ::: "memory")
#define PG8_WAIT_L(n) asm volatile("s_waitcnt lgkmcnt(" #n ")" ::: "memory")
#define PG8_BAR __builtin_amdgcn_s_barrier()
#define PG8_SCHED __builtin_amdgcn_sched_barrier(0)
    Unit cur, nxt; int ui = 0;
    if (!S.next(0, cur)) return;
    f32x4 acc[2][2][4][2];
#pragma unroll
    for (int a = 0; a < 2; ++a)
#pragma unroll
        for (int b = 0; b < 2; ++b)
#pragma unroll
            for (int m = 0; m < 4; ++m)
#pragma unroll
                for (int n = 0; n < 2; ++n) acc[a][b][m][n] = (f32x4){0.f, 0.f, 0.f, 0.f};
    pg8_v8i At[4], B0[2], B1[2];
    const char* cA = (const char*)g.A + (size_t)cur.pm * tstep + (size_t)cur.part * g.kpart; const char* cB = (const char*)g.Bt + S.boff(cur) + (size_t)cur.pn * tstep + (size_t)cur.part * g.kpart;
    S.a_ready(cur);
    if constexpr (Epi::AUX) { if (wid == 0) E.stage_aux(cur, lds + STAGE_BYTES + 1024, lane); }
    if constexpr (SP2) {
        PG8_STAGE(PG8_SB(0, 0), cB, voffB); PG8_STAGE(PG8_SB(0, 1), cB + hstep, voffB); PG8_STAGE(PG8_SA(0, 0), cA, voffA); PG8_STAGE(PG8_SA(0, 1), cA + hstep, voffA);
        if (wr == 1) PG8_BAR;
        PG8_WAIT_V(2); PG8_BAR;
        PG8_STAGE(PG8_SB(1, 0), cB + kstep, voffB); PG8_STAGE(PG8_SA(1, 0), cA + kstep, voffA); PG8_STAGE(PG8_SB(1, 1), cB + hstep + kstep, voffB);
        PG8_WAIT_V(6); PG8_BAR;
    } else {
        PG8_STAGE(PG8_SB(0, 0), cB, voffB); PG8_STAGE(PG8_SA(0, 0), cA, voffA); PG8_STAGE(PG8_SB(0, 1), cB + hstep, voffB); PG8_STAGE(PG8_SA(0, 1), cA + hstep, voffA);
        if (wr == 1) PG8_BAR;
        PG8_WAIT_V(4); PG8_BAR;
        PG8_STAGE(PG8_SB(1, 0), cB + kstep, voffB); PG8_STAGE(PG8_SA(1, 0), cA + kstep, voffA); PG8_STAGE(PG8_SB(1, 1), cB + hstep + kstep, voffB);
        PG8_WAIT_V(6); PG8_BAR;
    }
    for (;;) {
        const bool has_next = S.next(ui + 1, nxt);
        const char* nA = has_next ? (const char*)g.A + (size_t)nxt.pm * tstep + (size_t)nxt.part * g.kpart : cA; const char* nB = has_next ? (const char*)g.Bt + S.boff(nxt) + (size_t)nxt.pn * tstep + (size_t)nxt.part * g.kpart : cB;
#pragma unroll 1
        for (int t = 0; t < nt; t += 2) {
            const bool last = (t == nt - 2);
            const char* a1 = cA + (size_t)(t + 1) * kstep;
            const char* a2 = last ? nA : cA + (size_t)(t + 2) * kstep; const char* b2 = last ? nB : cB + (size_t)(t + 2) * kstep;
            const char* a3 = a2 + kstep; const char* b3 = b2 + kstep;
            if (last && has_next) S.a_ready(nxt);
            if constexpr (SP2) {
            PG8_LDB(B0, 0, 0); PG8_LDB(B1, 0, 1); PG8_SCHED; PG8_LDA(At, 0, 0); PG8_STAGE(PG8_SA(1, 1), a1 + hstep, voffA);
            PG8_WAIT_V(8); PG8_WAIT_L(0); PG8_BAR; PG8_MMA(0, 0, At, B0); PG8_MMA(0, 1, At, B1); PG8_BAR; PG8_SCHED;
            PG8_LDA(At, 0, 1); PG8_STAGE(PG8_SB(0, 0), b2, voffB); PG8_STAGE(PG8_SB(0, 1), b2 + hstep, voffB); PG8_STAGE(PG8_SA(0, 0), a2, voffA);
            PG8_WAIT_V(8); PG8_WAIT_L(0); PG8_BAR; PG8_MMA(1, 0, At, B0); PG8_MMA(1, 1, At, B1); PG8_BAR; PG8_SCHED;
            PG8_LDB(B0, 1, 0); PG8_LDB(B1, 1, 1); PG8_SCHED; PG8_LDA(At, 1, 0); PG8_STAGE(PG8_SA(0, 1), a2 + hstep, voffA);
            PG8_WAIT_V(8); PG8_WAIT_L(0); PG8_BAR; PG8_MMA(0, 0, At, B0); PG8_MMA(0, 1, At, B1); PG8_BAR; PG8_SCHED;
            PG8_LDA(At, 1, 1); PG8_STAGE(PG8_SB(1, 0), b3, voffB); PG8_STAGE(PG8_SB(1, 1), b3 + hstep, voffB); PG8_STAGE(PG8_SA(1, 0), a3, voffA);
            PG8_WAIT_V(8); PG8_WAIT_L(0); PG8_BAR; PG8_MMA(1, 0, At, B0); PG8_MMA(1, 1, At, B1); PG8_BAR; PG8_SCHED;
            } else {
            PG8_LDB(B0, 0, 0); PG8_SCHED; PG8_LDA(At, 0, 0); PG8_STAGE(PG8_SA(1, 1), a1 + hstep, voffA);
            PG8_WAIT_L(8); PG8_BAR; PG8_WAIT_L(0); PG8_MMA(0, 0, At, B0); PG8_BAR; PG8_SCHED;
            PG8_LDB(B1, 0, 1); PG8_STAGE(PG8_SB(0, 0), b2, voffB);
            PG8_BAR; PG8_WAIT_L(0); PG8_MMA(0, 1, At, B1); PG8_BAR;
            PG8_LDA(At, 0, 1); PG8_STAGE(PG8_SA(0, 0), a2, voffA);
            PG8_BAR; PG8_WAIT_L(0); PG8_MMA(1, 0, At, B0); PG8_BAR; PG8_SCHED;
            PG8_STAGE(PG8_SB(0, 1), b2 + hstep, voffB);
            PG8_WAIT_V(6); PG8_BAR; PG8_MMA(1, 1, At, B1); PG8_BAR;
            PG8_LDB(B0, 1, 0); PG8_SCHED; PG8_LDA(At, 1, 0); PG8_STAGE(PG8_SA(0, 1), a2 + hstep, voffA);
            PG8_WAIT_L(8); PG8_BAR; PG8_WAIT_L(0); PG8_MMA(0, 0, At, B0); PG8_BAR; PG8_SCHED;
            PG8_LDB(B1, 1, 1); PG8_STAGE(PG8_SB(1, 0), b3, voffB);
            PG8_BAR; PG8_WAIT_L(0); PG8_MMA(0, 1, At, B1); PG8_BAR;
            PG8_LDA(At, 1, 1); PG8_STAGE(PG8_SA(1, 0), a3, voffA);
            PG8_BAR; PG8_WAIT_L(0); PG8_MMA(1, 0, At, B0); PG8_BAR; PG8_SCHED;
            PG8_STAGE(PG8_SB(1, 1), b3 + hstep, voffB);
            PG8_WAIT_V(6); PG8_BAR; PG8_MMA(1, 1, At, B1); PG8_BAR;
            }
        }
        if constexpr (ALIGN_EPI) { if (wr == 0) PG8_BAR; }
        if constexpr (!Epi::AFTER_DRAIN) { if constexpr (Epi::AUX) { E(acc, cur, wr, wc, fr, fq, lds + STAGE_BYTES + 1024 + (ui & 1) * 2048); if (has_next && wid == 0) { int l_ = threadIdx.x; asm volatile("" : "+v"(l_)); E.stage_aux(nxt, lds + STAGE_BYTES + 1024 + ((ui + 1) & 1) * 2048, l_ & 63); } } else E(acc, cur, wr, wc, fr, fq); S.done(cur); }
        if (!has_next) break;
#pragma unroll
        for (int a = 0; a < 2; ++a)
#pragma unroll
            for (int b = 0; b < 2; ++b)
#pragma unroll
                for (int m = 0; m < 4; ++m)
#pragma unroll
                    for (int n = 0; n < 2; ++n) acc[a][b][m][n] = (f32x4){0.f, 0.f, 0.f, 0.f};
        cur = nxt; cA = nA; cB = nB; ++ui;
        if constexpr (ALIGN_EPI) { if (wr == 1) PG8_BAR; }
    }
    PG8_WAIT_V(0);
    if constexpr (!ALIGN_EPI) { if (wr == 0) PG8_BAR; }
    PG8_BAR;
    if constexpr (Epi::AFTER_DRAIN) { E.fused(acc, cur, wr, wc, fr, fq, lds, wid, lane); S.done(cur); }
#undef PG8_SA
#undef PG8_SB
#undef PG8_STAGE
#undef PG8_LDA
#undef PG8_LDB
#undef PG8_LD32
#undef PG8_LO
#undef PG8_HI
#undef PG8_MMA
#undef PG8_WAIT_V
#undef PG8_WAIT_L
#undef PG8_BAR
#undef PG8_SCHED
}
}

#include <hip/hip_bf16.h>
#include <cmath>
namespace attn_body {
using bf16=__hip_bfloat16;
using bf16x8=__attribute__((ext_vector_type(8)))short;
using s16x4=__attribute__((ext_vector_type(4)))short;
using f32x16=__attribute__((ext_vector_type(16)))float;
using u32x4=__attribute__((ext_vector_type(4)))unsigned;
constexpr int D=64;
constexpr int NW=8,QBLK=32,QB=QBLK*NW,KVBLK=64;
constexpr int ATTN_UNIT_ROWS=QB;
__device__ __forceinline__ int crow(int r,int hi){return (r&3)+8*(r>>2)+4*hi;}
#define SBAR() __builtin_amdgcn_sched_barrier(0)
__device__ __forceinline__ void selmask(f32x16&p0,f32x16&p1,unsigned sel,int n){
  const float lim=((sel>>n)&1u)?INFINITY:-INFINITY;
  #pragma unroll
  for(int r=0;r<16;++r){p0[r]=__builtin_fminf(p0[r],lim);p1[r]=__builtin_fminf(p1[r],lim);}
}
__device__ __forceinline__ void cmask(f32x16&p0,f32x16&p1,int jb,int qrel,int hi){
  const float NEG=-INFINITY; int kb=64*jb+4*hi;
  #pragma unroll
  for(int r=0;r<16;++r){int kv=kb+(r&3)+8*(r>>2); if(kv>qrel)p0[r]=NEG; if(kv+32>qrel)p1[r]=NEG;}
}

constexpr int NSLOT=4, SLOTB=8192;
constexpr int LDS_K=0, LDS_V=NSLOT*SLOTB, LDS_WS=2*NSLOT*SLOTB, LDS_OST=LDS_WS+NW*64*4, LDS_CW=LDS_OST+NW*4096, LDS_BYTES=LDS_CW+NW*512;
constexpr float C2=0.125f*1.4426950408889634f;
__device__ __forceinline__ void glds16(const void*gsrc,unsigned lds_dst){unsigned keep;
  asm volatile("s_mov_b32 %0, m0\n\ts_mov_b32 m0, %2\n\ts_nop 0\n\tglobal_load_lds_dwordx4 %1, off\n\ts_mov_b32 m0, %0":"=&s"(keep):"v"(gsrc),"s"(lds_dst):"memory");}
__device__ __forceinline__ float max3f(float a,float b,float c){float r;asm("v_max3_f32 %0, %1, %2, %3":"=v"(r):"v"(a),"v"(b),"v"(c));return r;}
__device__ __forceinline__ float max2f(float a,float b){float r;asm("v_max_f32_e32 %0, %1, %2":"=v"(r):"v"(a),"v"(b));return r;}
__device__ __forceinline__ float fadd_s(float a,float b){float r;asm("v_add_f32_e32 %0, %1, %2":"=v"(r):"v"(a),"v"(b));return r;}
__device__ __forceinline__ float fsub_s(float a,float b){float r;asm("v_sub_f32_e32 %0, %1, %2":"=v"(r):"v"(a),"v"(b));return r;}
typedef float f32x2_t __attribute__((ext_vector_type(2))); typedef __bf16 bf16x2_t __attribute__((ext_vector_type(2)));
__device__ __forceinline__ unsigned cvtpk_s(float lo,float hi){f32x2_t v={lo,hi};bf16x2_t b=__builtin_convertvector(v,bf16x2_t);return __builtin_bit_cast(unsigned,b);}
#define WAIT_BAR(N) do{ if(ATTN_RESIDENT) asm volatile("s_waitcnt lgkmcnt(0)\n\ts_barrier":::"memory"); else asm volatile("s_waitcnt vmcnt(" #N ") lgkmcnt(0)\n\ts_barrier":::"memory"); }while(0)

__device__ __forceinline__ void qkt(f32x16&p0,f32x16&p1,const char*Kslot,const bf16x8*qr,const f32x16&negm,int r32,int hi){
  const char*kb=Kslot+hi*1024+r32*16;
  #pragma unroll
  for(int d0=0;d0<4;++d0){
    const bf16x8 b0=*reinterpret_cast<const bf16x8*>(kb+d0*2048);
    const bf16x8 b1=*reinterpret_cast<const bf16x8*>(kb+d0*2048+512);
    if(d0==0){p0=__builtin_amdgcn_mfma_f32_32x32x16_bf16(b0,qr[0],negm,0,0,0);p1=__builtin_amdgcn_mfma_f32_32x32x16_bf16(b1,qr[0],negm,0,0,0);}
    else{p0=__builtin_amdgcn_mfma_f32_32x32x16_bf16(b0,qr[d0],p0,0,0,0);p1=__builtin_amdgcn_mfma_f32_32x32x16_bf16(b1,qr[d0],p1,0,0,0);}}
}
typedef __attribute__((address_space(3))) const char* lds_cptr;
typedef short v4i16_t __attribute__((ext_vector_type(4)));
__device__ __forceinline__ void kload8(bf16x8*kf,lds_cptr kp){
  kf[0]=*(const __attribute__((address_space(3))) bf16x8*)(kp);      kf[1]=*(const __attribute__((address_space(3))) bf16x8*)(kp+512);
  kf[2]=*(const __attribute__((address_space(3))) bf16x8*)(kp+2048); kf[3]=*(const __attribute__((address_space(3))) bf16x8*)(kp+2560);
  kf[4]=*(const __attribute__((address_space(3))) bf16x8*)(kp+4096); kf[5]=*(const __attribute__((address_space(3))) bf16x8*)(kp+4608);
  kf[6]=*(const __attribute__((address_space(3))) bf16x8*)(kp+6144); kf[7]=*(const __attribute__((address_space(3))) bf16x8*)(kp+6656);
}
__device__ __forceinline__ void kload2(bf16x8*kf,lds_cptr kp,int j){ kf[2*j]=*(const __attribute__((address_space(3))) bf16x8*)(kp+j*2048); kf[2*j+1]=*(const __attribute__((address_space(3))) bf16x8*)(kp+j*2048+512); }
__device__ __forceinline__ s16x4 vtr(lds_cptr p){ return __builtin_bit_cast(s16x4,__builtin_amdgcn_ds_read_tr16_b64_v4i16((__attribute__((address_space(3))) v4i16_t*)p)); }
__device__ __forceinline__ float rowmax(const f32x16&p0,const f32x16&p1){
  float a=max3f(p0[0],p0[1],p1[0]),b=max3f(p0[2],p0[3],p1[1]);a=max3f(a,p1[2],p1[3]);
  #pragma unroll
  for(int r=4;r<16;r+=4){a=max3f(a,p0[r],p0[r+1]);b=max3f(b,p0[r+2],p0[r+3]);a=max3f(a,p1[r],p1[r+1]);b=max3f(b,p1[r+2],p1[r+3]);}
  const float m=max2f(a,b);
  auto rr=__builtin_amdgcn_permlane32_swap(__float_as_uint(m),__float_as_uint(m),false,false);
  return max2f(__uint_as_float(rr[0]),__uint_as_float(rr[1]));
}
__device__ __forceinline__ void pv(f32x16*o,int vb,bf16x8 pa0,bf16x8 pa1,bf16x8 pa2,bf16x8 pa3){
  #pragma unroll
  for(int d0=0;d0<2;++d0){s16x4 lo[4],hi[4];
    #pragma unroll
    for(int ks=0;ks<4;++ks){
      asm volatile("ds_read_b64_tr_b16 %0,%1 offset:%c2":"=&v"(lo[ks]):"v"(vb),"i"(d0*4096+ks*1024):"memory");
      asm volatile("ds_read_b64_tr_b16 %0,%1 offset:%c2":"=&v"(hi[ks]):"v"(vb),"i"(d0*4096+ks*1024+512):"memory");}
    asm volatile("s_waitcnt lgkmcnt(0)":::"memory");SBAR();
    #define PK(k) (bf16x8){lo[k][0],lo[k][1],lo[k][2],lo[k][3],hi[k][0],hi[k][1],hi[k][2],hi[k][3]}
    o[d0]=__builtin_amdgcn_mfma_f32_32x32x16_bf16(pa0,PK(0),o[d0],0,0,0);
    o[d0]=__builtin_amdgcn_mfma_f32_32x32x16_bf16(pa1,PK(1),o[d0],0,0,0);
    o[d0]=__builtin_amdgcn_mfma_f32_32x32x16_bf16(pa2,PK(2),o[d0],0,0,0);
    o[d0]=__builtin_amdgcn_mfma_f32_32x32x16_bf16(pa3,PK(3),o[d0],0,0,0);
    #undef PK
  }
}


template<bool PICKS=false> __device__ __forceinline__ unsigned moba_select(const bf16x8*qr,const float*kmean,int own,int r32,int hi,const float*kmean2=nullptr){
  f32x16 g=f32x16{};
  #pragma unroll
  for(int d0=0;d0<4;++d0){
    const float*kp=kmean+r32*64+d0*16+hi*8; float4 a=*(const float4*)kp,b=*(const float4*)(kp+4);
    if(kmean2){ const float*kq=kmean2+r32*64+d0*16+hi*8; const float4 a2=*(const float4*)kq,b2=*(const float4*)(kq+4); const float sc_=1.0f/256.0f;
      a.x=(a.x+a2.x)*sc_; a.y=(a.y+a2.y)*sc_; a.z=(a.z+a2.z)*sc_; a.w=(a.w+a2.w)*sc_; b.x=(b.x+b2.x)*sc_; b.y=(b.y+b2.y)*sc_; b.z=(b.z+b2.z)*sc_; b.w=(b.w+b2.w)*sc_; }
    const float x[8]={a.x,a.y,a.z,a.w,b.x,b.y,b.z,b.w}; bf16x8 kh,kl;
    #pragma unroll
    for(int i=0;i<8;++i){ const unsigned u=__float_as_uint(x[i]); const unsigned hb=(u+0x7fffu+((u>>16)&1u))>>16; const float rem=x[i]-__uint_as_float(hb<<16);
      const unsigned v=__float_as_uint(rem); const unsigned lb=(v+0x7fffu+((v>>16)&1u))>>16; kh[i]=(short)hb; kl[i]=(short)lb; }
    g=__builtin_amdgcn_mfma_f32_32x32x16_bf16(kh,qr[d0],g,0,0,0); g=__builtin_amdgcn_mfma_f32_32x32x16_bf16(kl,qr[d0],g,0,0,0);
  }
  float v0=-INFINITY,v1=-INFINITY,v2=-INFINITY; int i0=64,i1=64,i2=64;
  #pragma unroll
  for(int r=0;r<16;++r){ const int n=crow(r,hi); const float x=(n<own)?g[r]:-INFINITY;
    if(x>v0){v2=v1;i2=i1;v1=v0;i1=i0;v0=x;i0=n;} else if(x>v1){v2=v1;i2=i1;v1=x;i1=n;} else if(x>v2){v2=x;i2=n;} }
  float pv[3]; int pi[3];
  pv[0]=__shfl_xor(v0,32); pv[1]=__shfl_xor(v1,32); pv[2]=__shfl_xor(v2,32); pi[0]=__shfl_xor(i0,32); pi[1]=__shfl_xor(i1,32); pi[2]=__shfl_xor(i2,32);
  #pragma unroll
  for(int k=0;k<3;++k){ const float x=pv[k]; const int n=pi[k];
    if(x>v0||(x==v0&&n<i0)){v2=v1;i2=i1;v1=v0;i1=i0;v0=x;i0=n;} else if(x>v1||(x==v1&&n<i1)){v2=v1;i2=i1;v1=x;i1=n;} else if(x>v2||(x==v2&&n<i2)){v2=x;i2=n;} }
  if(PICKS){ const unsigned nv=(v0>-INFINITY?1u:0u)+(v1>-INFINITY?1u:0u)+(v2>-INFINITY?1u:0u); return (unsigned)(i0&0xff)|((unsigned)(i1&0xff)<<8)|((unsigned)(i2&0xff)<<16)|(nv<<24); }
  unsigned sel=0u; if(v0>-INFINITY)sel|=1u<<i0; if(v1>-INFINITY)sel|=1u<<i1; if(v2>-INFINITY)sel|=1u<<i2;
  return sel;
}
#ifndef ATTN_STORE16
#define ATTN_STORE16(p,v) (*(u32x4*)(p)=(v))
#endif
struct AttnX { const unsigned short* list; int nvalid; bf16* part_o; float* part_ml; long bhrow; int own; int resident; int preissued; const bf16* nK; const bf16* nV; };
template<int THRL,int MODE,int QP,int KP,int OP> __device__ __forceinline__ void attn_unit(int qb,const bf16*Qw0,const bf16*__restrict__ Kh,const bf16*__restrict__ Vh,bf16*Ow0,const float*kmean,char*shm,const AttnX x,const bf16x8*qpre=nullptr){
  static_assert(MODE!=1,"MODE 1 needs the three-slot K ring");
  int tid_=threadIdx.x; asm volatile("":"+v"(tid_));
  const int tid=tid_,lane=tid&63,r32=lane&31,hi=lane>>5; const int wid=__builtin_amdgcn_readfirstlane(tid>>6);
  const bf16*Qw=Qw0+(long)(wid*QBLK)*QP;
  constexpr bool MOBA=(MODE==1);
  const bool ATTN_RESIDENT=(x.resident!=0);
  const unsigned lds0=(unsigned)(uintptr_t)shm;
  float*wsf=(float*)(shm+LDS_WS)+wid*64;
  const bf16*ksrc=Kh+(long)lane*KP+wid*8;
  const bf16*vsrc=Vh+(long)(16*(wid&3)+(lane>>2))*KP+(wid>>2)*32+(lane&3)*8;
  const unsigned kdst=lds0+LDS_K+wid*1024, vdst=lds0+LDS_V+wid*1024;
  #define DMA_K(t,slot) do{ if(!x.resident) glds16(ksrc+(long)(t)*KVBLK*KP,(unsigned)__builtin_amdgcn_readfirstlane(kdst+(slot))); }while(0)
  #define DMA_V(t,slot) do{ if(!x.resident) glds16(vsrc+(long)(t)*KVBLK*KP,(unsigned)__builtin_amdgcn_readfirstlane(vdst+(slot))); }while(0)
  const int vb0=(int)(lds0+LDS_V)+((lane>>4)&1)*32+(lane&3)*8+(4*hi+((lane&15)>>2))*64;
  const char*Kbase=shm+LDS_K; bf16x8 kf[8];
  const lds_cptr shm3=(lds_cptr)shm; const lds_cptr kp0=shm3+LDS_K+hi*1024+r32*16; const lds_cptr vp0=shm3+LDS_V+((lane>>4)&1)*32+(lane&3)*8+(4*hi+((lane&15)>>2))*64;
  const int NT=(MODE==1)?4*qb+4:4;
  if(!x.preissued){ DMA_K(0,0);DMA_V(0,0);DMA_K(1,SLOTB); }
  bf16x8 qr[4];
  #pragma unroll
  for(int d0=0;d0<4;++d0){ if(MODE==2&&qpre){ qr[d0]=qpre[d0]; } else if(MODE==2){ const int li=wid*QBLK+r32; const unsigned e=x.list[li<x.nvalid?li:0]; qr[d0]=*reinterpret_cast<const bf16x8*>(&Qw0[(long)(e&0x1fffu)*QP+d0*16+hi*8]); }
    else qr[d0]=*reinterpret_cast<const bf16x8*>(&Qw[(long)r32*QP+d0*16+hi*8]); }
  unsigned sel=0u; if(MOBA) sel=moba_select(qr,kmean,qb,r32,hi);
  unsigned el[4]={0u,0u,0u,0u},eml=0u;
  if(MODE==2){
    #pragma unroll
    for(int i=0;i<4;++i){ const int li=wid*QBLK+i*8+(lane>>3); if(li<x.nvalid) el[i]=x.list[li]; }
    { const int li=wid*QBLK+r32; if(li<x.nvalid) eml=x.list[li]; } }
  float ms3[3]={-INFINITY,-INFINITY,-INFINITY},ls3[3]={0.f,0.f,0.f};
  if(MODE==3){ const float*ml=x.part_ml+((x.bhrow+(long)(x.own*QB+wid*QBLK+r32))*3)*2; const int nsel0=x.own<3?x.own:3;
    #pragma unroll
    for(int s_=0;s_<3;++s_) if(s_<nsel0){ ms3[s_]=ml[2*s_]; ls3[s_]=ml[2*s_+1]; } }
  float mhat=0.f,l_reg=0.f;f32x16 o[2];o[0]=f32x16{};o[1]=f32x16{};f32x16 negm=f32x16{};asm volatile("":"+v"(negm));
  const int qrel=wid*QBLK+r32;
  #define CMASK(P0,P1,t) do{ if(MODE==1||MODE==3){int jb_=(t)-(NT-4); if(jb_>=0)cmask(P0,P1,jb_,qrel,hi); else if(MODE==1)selmask(P0,P1,sel,(t)>>2);} }while(0)
  bool resc=false;
  #define START(P0,P1) do{ const float rm=rowmax(P0,P1); resc=false; \
    { const float dl=MOBA?__builtin_fmaxf(rm,-256.f):rm; mhat=fadd_s(mhat,dl); \
      _Pragma("unroll") for(int r=0;r<16;++r){P0[r]=fsub_s(P0[r],dl);P1[r]=fsub_s(P1[r],dl);} \
      _Pragma("unroll") for(int r=0;r<16;++r)negm[r]=-mhat; asm volatile("":"+v"(negm)); } \
    _Pragma("unroll") for(int r=0;r<16;++r)P0[r]=__builtin_amdgcn_exp2f(P0[r]); }while(0)
  #define RESC() do{ if(resc){ asm volatile("s_waitcnt lgkmcnt(0)":::"memory"); \
      _Pragma("unroll") for(int d_=0;d_<2;++d_) _Pragma("unroll") for(int r=0;r<16;++r)o[d_][r]*=wsf[crow(r,hi)]; } }while(0)
  f32x16 pA0,pA1,pB0,pB1;
  int sl_prev=0,sl_cur=0,sl_next=SLOTB;
  #define ROT() do{sl_prev=sl_cur;sl_cur=sl_next;sl_next=(sl_next==(NSLOT-1)*SLOTB)?0:sl_next+SLOTB;}while(0)
  DMA_K(2,2*SLOTB);
  WAIT_BAR(3);
  qkt(pA0,pA1,Kbase,qr,negm,r32,hi);asm volatile("s_nop 15\n\ts_nop 7":"+v"(pA0),"+v"(pA1));CMASK(pA0,pA1,0);
  START(pA0,pA1);
  _Pragma("unroll") for(int r=0;r<16;++r)pA1[r]=__builtin_amdgcn_exp2f(pA1[r]);
  WAIT_BAR(0);
  DMA_K(3,3*SLOTB);DMA_V(1,SLOTB);
  ROT();
  kload8(kf,kp0+sl_cur);
  WAIT_BAR(2);
  s16x4 vlo[8],vhi[8]; u32x4 pw0,pw1,pw2,pw3;
  #define PKW(P,B) cvtpk_s(P[B],P[B+1])
  #define PAF(k) __builtin_bit_cast(bf16x8,pw##k)
  #define VFR(i) (bf16x8){vlo[i][0],vlo[i][1],vlo[i][2],vlo[i][3],vhi[i][0],vhi[i][1],vhi[i][2],vhi[i][3]}
  #define PIN(x) asm volatile("":"+v"(x))
  #define MX3(a,b,c) __builtin_fmaxf(__builtin_fmaxf((a),(b)),(c))
  #define GAPA(MF,A0,A1,A2,A3,W0,W1,PW) do{ MF; sacc+=A0; sacc+=A1; sacc+=A2; sacc+=A3; PIN(sacc); W0; W1; PIN(PW); SBAR(); }while(0)
  #define EX(v) __builtin_amdgcn_exp2f(v)
  #define GAPB(MF,X,B) do{ MF; X[B]=EX(X[B]); X[B+1]=EX(X[B+1]); X[B+2]=EX(X[B+2]); X[B+3]=EX(X[B+3]); PIN(X); SBAR(); }while(0)
  #define VRD(i) do{ vlo[i]=vtr(vp_+(((i)>>2)*4096+((i)&3)*1024)); vhi[i]=vtr(vp_+(((i)>>2)*4096+((i)&3)*1024+512)); }while(0)
  #define KRD(G,j) do{ if(G){ kload2(kf,kp0+sl_next,j); SBAR(); } }while(0)
  #define STEP(C0,C1,P0,P1,t,GK,GV,GL) do{ SBAR(); \
    const lds_cptr vp_=vp0+sl_prev; \
    VRD(0); SBAR(); float sacc=(P0[0]+P0[1]); \
    GAPA(C0=__builtin_amdgcn_mfma_f32_32x32x16_bf16(kf[0],qr[0],negm,0,0,0), P0[2],P0[3],P0[4],P0[5],     pw0[0]=PKW(P0,0), pw0[1]=PKW(P0,2), pw0); \
    VRD(4); SBAR(); GAPA(C1=__builtin_amdgcn_mfma_f32_32x32x16_bf16(kf[1],qr[0],negm,0,0,0), P0[6],P0[7],P0[8],P0[9],     pw0[2]=PKW(P0,4), pw0[3]=PKW(P0,6), pw0); \
    VRD(1); SBAR(); GAPA(C0=__builtin_amdgcn_mfma_f32_32x32x16_bf16(kf[2],qr[1],C0,0,0,0),   P0[10],P0[11],P0[12],P0[13], pw1[0]=PKW(P0,8), pw1[1]=PKW(P0,10), pw1); \
    VRD(5); SBAR(); GAPA(C1=__builtin_amdgcn_mfma_f32_32x32x16_bf16(kf[3],qr[1],C1,0,0,0),   P0[14],P0[15],P1[0],P1[1],   pw1[2]=PKW(P0,12),pw1[3]=PKW(P0,14), pw1); \
    VRD(2); SBAR(); GAPA(C0=__builtin_amdgcn_mfma_f32_32x32x16_bf16(kf[4],qr[2],C0,0,0,0),   P1[2],P1[3],P1[4],P1[5],     pw2[0]=PKW(P1,0), pw2[1]=PKW(P1,2), pw2); \
    VRD(6); SBAR(); GAPA(C1=__builtin_amdgcn_mfma_f32_32x32x16_bf16(kf[5],qr[2],C1,0,0,0),   P1[6],P1[7],P1[8],P1[9],     pw2[2]=PKW(P1,4), pw2[3]=PKW(P1,6), pw2); \
    VRD(3); SBAR(); GAPA(C0=__builtin_amdgcn_mfma_f32_32x32x16_bf16(kf[6],qr[3],C0,0,0,0),   P1[10],P1[11],P1[12],P1[13], pw3[0]=PKW(P1,8), pw3[1]=PKW(P1,10), pw3); \
    VRD(7); SBAR(); GAPA(C1=__builtin_amdgcn_mfma_f32_32x32x16_bf16(kf[7],qr[3],C1,0,0,0),   P1[14],P1[15],0.f,0.f,       pw3[2]=PKW(P1,12),pw3[3]=PKW(P1,14), pw3); \
    l_reg+=sacc; \
    if(GK){DMA_K((t)+3,sl_cur);} if(GV){DMA_V((t)+1,sl_next);} \
    CMASK(C0,C1,t); \
    { float a=MX3(C0[0],C0[1],C1[0]),b=MX3(C0[2],C0[3],C1[1]); a=MX3(a,C1[2],C1[3]); \
      _Pragma("unroll") for(int r=4;r<16;r+=4){a=MX3(a,C0[r],C0[r+1]);b=MX3(b,C0[r+2],C0[r+3]);a=MX3(a,C1[r],C1[r+1]);b=MX3(b,C1[r+2],C1[r+3]);} \
      float rm=__builtin_fmaxf(a,b); { auto rr=__builtin_amdgcn_permlane32_swap(__float_as_uint(rm),__float_as_uint(rm),false,false); rm=__builtin_fmaxf(__uint_as_float(rr[0]),__uint_as_float(rr[1])); } \
      resc=false; \
      if(__builtin_expect(__any(rm>(float)THRL),0)){ const float dl=(rm>(float)THRL)?rm:0.f;     mhat+=dl; \
        _Pragma("unroll") for(int r=0;r<16;++r){C0[r]-=dl;C1[r]-=dl;} \
        _Pragma("unroll") for(int r=0;r<16;++r)negm[r]=-mhat; asm volatile("":"+v"(negm)); \
        const float f=__builtin_amdgcn_exp2f(-dl); l_reg*=f; if(hi==0)wsf[r32]=f; resc=true; } } \
    SBAR(); \
    GAPB(o[0]=__builtin_amdgcn_mfma_f32_32x32x16_bf16(PAF(0),VFR(0),o[0],0,0,0), C0,0); \
    GAPB(o[1]=__builtin_amdgcn_mfma_f32_32x32x16_bf16(PAF(0),VFR(4),o[1],0,0,0), C0,4); \
    KRD(GL,0); GAPB(o[0]=__builtin_amdgcn_mfma_f32_32x32x16_bf16(PAF(1),VFR(1),o[0],0,0,0), C0,8); \
    KRD(GL,1); GAPB(o[1]=__builtin_amdgcn_mfma_f32_32x32x16_bf16(PAF(1),VFR(5),o[1],0,0,0), C0,12); \
    KRD(GL,2); GAPB(o[0]=__builtin_amdgcn_mfma_f32_32x32x16_bf16(PAF(2),VFR(2),o[0],0,0,0), C1,0); \
    KRD(GL,3); GAPB(o[1]=__builtin_amdgcn_mfma_f32_32x32x16_bf16(PAF(2),VFR(6),o[1],0,0,0), C1,4); \
    GAPB(o[0]=__builtin_amdgcn_mfma_f32_32x32x16_bf16(PAF(3),VFR(3),o[0],0,0,0), C1,8); \
    GAPB(o[1]=__builtin_amdgcn_mfma_f32_32x32x16_bf16(PAF(3),VFR(7),o[1],0,0,0), C1,12); \
    }while(0)
  int t=1;
  #undef CMASK
  #define CMASK(P0,P1,t) do{ if(MOBA)selmask(P0,P1,sel,(t)>>2); }while(0)
  for(;t+5<NT;t+=2){
    STEP(pB0,pB1,pA0,pA1,t,true,true,true);     WAIT_BAR(2); RESC(); ROT();
    STEP(pA0,pA1,pB0,pB1,t+1,true,true,true);   WAIT_BAR(2); RESC(); ROT();
  }
  #undef CMASK
  #define CMASK(P0,P1,t) do{ if(MODE==1||MODE==3){int jb_=(t)-(NT-4); if(jb_>=0)cmask(P0,P1,jb_,qrel,hi); else if(MODE==1)selmask(P0,P1,sel,(t)>>2);} }while(0)
  #define ENDW(tt) do{ if((tt)+3<NT){WAIT_BAR(2);} else if((tt)+2<NT){WAIT_BAR(1);} else {WAIT_BAR(0);} }while(0)
  for(;t+1<NT;t+=2){
    STEP(pB0,pB1,pA0,pA1,t,(t+3<NT),(t+1<NT),(t+1<NT));       ENDW(t);   RESC(); ROT();
    STEP(pA0,pA1,pB0,pB1,t+1,(t+4<NT),(t+2<NT),(t+2<NT));     ENDW(t+1); RESC(); ROT();
  }
  if(x.nK){
    const bf16*ksn=x.nK+(long)lane*KP+wid*8; const bf16*vsn=x.nV+(long)(16*(wid&3)+(lane>>2))*KP+(wid>>2)*32+(lane&3)*8;
    glds16(ksn,(unsigned)__builtin_amdgcn_readfirstlane(kdst)); glds16(vsn,(unsigned)__builtin_amdgcn_readfirstlane(vdst)); glds16(ksn+(long)KVBLK*KP,(unsigned)__builtin_amdgcn_readfirstlane(kdst+SLOTB)); }
  STEP(pB0,pB1,pA0,pA1,NT-1,false,false,false); RESC();
  { float sacc=pB0[0]+pB0[1]; _Pragma("unroll") for(int r=2;r<16;++r)sacc+=pB0[r]; _Pragma("unroll") for(int r=0;r<16;++r)sacc+=pB1[r]; l_reg+=sacc;
    pw0=(u32x4){PKW(pB0,0),PKW(pB0,2),PKW(pB0,4),PKW(pB0,6)};pw1=(u32x4){PKW(pB0,8),PKW(pB0,10),PKW(pB0,12),PKW(pB0,14)};pw2=(u32x4){PKW(pB1,0),PKW(pB1,2),PKW(pB1,4),PKW(pB1,6)};pw3=(u32x4){PKW(pB1,8),PKW(pB1,10),PKW(pB1,12),PKW(pB1,14)};
    SBAR(); pv(o,vb0+sl_cur,PAF(0),PAF(1),PAF(2),PAF(3)); }
  #undef PKW
  #undef PAF
  #undef VFR
  #undef PIN
  #undef MX3
  #undef GAPA
  #undef GAPB
  #undef EX
  #undef VRD
  #undef KRD
  #undef STEP
  #undef ENDW
  {auto rr=__builtin_amdgcn_permlane32_swap(__float_as_uint(l_reg),__float_as_uint(l_reg),false,false);l_reg=__uint_as_float(rr[0])+__uint_as_float(rr[1]);}
  float*cw=(float*)(shm+LDS_CW)+wid*128;
  const int nsel=x.own<3?x.own:3;
  u32x4 pp[4][3];
  if(MODE==3){
    #pragma unroll
    for(int i=0;i<4;++i){ const bf16*po=x.part_o+((x.bhrow+(long)(x.own*QB+wid*QBLK+i*8+(lane>>3)))*3)*64+(lane&7)*8;
      #pragma unroll
      for(int s_=0;s_<3;++s_){ pp[i][s_]=u32x4{0u,0u,0u,0u}; if(s_<nsel) pp[i][s_]=*(const u32x4*)(po+s_*64); } } }
  if(hi==0){ wsf[32+r32]=l_reg;
    if(MODE==2){ const int li=wid*QBLK+r32; if(li<x.nvalid){ const unsigned e=eml; float*ml=x.part_ml+((x.bhrow+(long)(e&0x1fffu))*3+(e>>13))*2; ml[0]=mhat; ml[1]=l_reg; } }
    if(MODE==3){ float ms[3],ls[3]; float Mx=mhat;
      #pragma unroll
      for(int s_=0;s_<3;++s_){ ms[s_]=ms3[s_]; ls[s_]=ls3[s_]; if(s_<nsel) Mx=__builtin_fmaxf(Mx,ms[s_]); }
      float wo=__builtin_amdgcn_exp2f(mhat-Mx)*l_reg, L=wo, w_[3];
      #pragma unroll
      for(int s_=0;s_<3;++s_){ w_[s_]=(s_<nsel)?ls[s_]*__builtin_amdgcn_exp2f(ms[s_]-Mx):0.f; L+=w_[s_]; }
      const float inv=1.0f/L; cw[r32*4]=wo*inv; cw[r32*4+1]=w_[0]*inv; cw[r32*4+2]=w_[1]*inv; cw[r32*4+3]=w_[2]*inv; } }
  asm volatile("s_waitcnt lgkmcnt(0)":::"memory");
  float rli[16];
  #pragma unroll
  for(int r=0;r<16;++r)rli[r]=__builtin_amdgcn_rcpf(wsf[32+crow(r,hi)]);
  bf16*Ow=Ow0+(long)(wid*QBLK)*OP;
  { bf16*stg=(bf16*)(shm+LDS_OST)+wid*2048;
    #pragma unroll
    for(int r=0;r<16;++r){const int orow=crow(r,hi);
      #pragma unroll
      for(int d0=0;d0<2;++d0)stg[orow*64+d0*32+r32]=__float2bfloat16(o[d0][r]*rli[r]);}
    asm volatile("s_waitcnt lgkmcnt(0)":::"memory");
    #pragma unroll
    for(int i=0;i<4;++i){const int row=i*8+(lane>>3),ch=lane&7; const u32x4 v=*(const u32x4*)(stg+row*64+ch*8);
      if(MODE==2){ const int li=wid*QBLK+row; if(li<x.nvalid){ const unsigned e=el[i]; ATTN_STORE16(x.part_o+((x.bhrow+(long)(e&0x1fffu))*3+(e>>13))*64+ch*8,v); } }
      else if(MODE==3){ const float c0=cw[row*4]; float f[8];
        f[0]=c0*__uint_as_float(v.x<<16); f[1]=c0*__uint_as_float(v.x&0xffff0000u); f[2]=c0*__uint_as_float(v.y<<16); f[3]=c0*__uint_as_float(v.y&0xffff0000u);
        f[4]=c0*__uint_as_float(v.z<<16); f[5]=c0*__uint_as_float(v.z&0xffff0000u); f[6]=c0*__uint_as_float(v.w<<16); f[7]=c0*__uint_as_float(v.w&0xffff0000u);
        #pragma unroll
        for(int s_=0;s_<3;++s_){ if(s_<nsel){ const float cs_=cw[row*4+1+s_]; const u32x4 p=pp[i][s_];
          f[0]+=cs_*__uint_as_float(p.x<<16); f[1]+=cs_*__uint_as_float(p.x&0xffff0000u); f[2]+=cs_*__uint_as_float(p.y<<16); f[3]+=cs_*__uint_as_float(p.y&0xffff0000u);
          f[4]+=cs_*__uint_as_float(p.z<<16); f[5]+=cs_*__uint_as_float(p.z&0xffff0000u); f[6]+=cs_*__uint_as_float(p.w<<16); f[7]+=cs_*__uint_as_float(p.w&0xffff0000u); } }
        u32x4 w; w.x=cvtpk_s(f[0],f[1]); w.y=cvtpk_s(f[2],f[3]); w.z=cvtpk_s(f[4],f[5]); w.w=cvtpk_s(f[6],f[7]); ATTN_STORE16(Ow+(long)row*OP+ch*8,w); }
      else ATTN_STORE16(Ow+(long)row*OP+ch*8,v);} }
  asm volatile("s_waitcnt lgkmcnt(0)\n\ts_barrier":::"memory");
  #undef DMA_K
  #undef DMA_V
  #undef CMASK
  #undef START
  #undef RESC
  #undef ROT
}
constexpr int ATTN_LDS_BYTES=LDS_BYTES;
#undef SBAR
#undef WAIT_BAR
}
#define GAS __attribute__((address_space(1)))
#define LAS __attribute__((address_space(3)))
typedef unsigned short bf16;
typedef unsigned v4u __attribute__((ext_vector_type(4)));
typedef float f32x4 __attribute__((ext_vector_type(4)));
typedef short bf16x8 __attribute__((ext_vector_type(8)));
typedef GAS unsigned gu32;
typedef GAS unsigned long long gu64;
#define RLX_AGENT __ATOMIC_RELAXED, __HIP_MEMORY_SCOPE_AGENT
#define LDS_WAIT() asm volatile("s_waitcnt lgkmcnt(0)" ::: "memory")
#define VM_WAIT() asm volatile("s_waitcnt vmcnt(0)" ::: "memory")
__device__ __forceinline__ unsigned long long rt() { return __builtin_amdgcn_s_memrealtime(); }
__device__ __forceinline__ unsigned f2bf(float f) { unsigned u = __builtin_bit_cast(unsigned, f); return (u + 0x7fffu + ((u >> 16) & 1u)) >> 16; }
__device__ __forceinline__ unsigned pk2(float lo, float hi) { return f2bf(lo) | (f2bf(hi) << 16); }
#define XB_TMO      128
#define XB_XCNT(j)  (256  + 64 * (j))
#define XB_XSUB(j)  (1280 + 64 * (j))
#define XB_XGEN(j)  (2304 + 64 * (j))
#define XB_TOP      3328
#define XB_TOPGEN   3392
#define XCD_BAR_WORDS 3456
#define XB_SPIN_CAP (1u << 22)

__device__ __forceinline__ unsigned xb_ld(unsigned* p)              { return __hip_atomic_load(p, __ATOMIC_RELAXED, __HIP_MEMORY_SCOPE_AGENT); }
__device__ __forceinline__ unsigned xb_add(unsigned* p, unsigned v) { return __hip_atomic_fetch_add(p, v, __ATOMIC_RELAXED, __HIP_MEMORY_SCOPE_AGENT); }
__device__ __forceinline__ unsigned xb_xcc_id() { return (unsigned)__builtin_amdgcn_s_getreg((3 << 11) | 20) & 0xFu; }
#define XB_SPIN(cond, bar) do { unsigned _sp = 0; while (cond) { __builtin_amdgcn_s_sleep(1); \
    if ((++_sp & 255u) == 0u) { if (xb_ld(&(bar)[XB_TMO])) break; if (_sp > XB_SPIN_CAP) { atomicAdd(&(bar)[XB_TMO], 1u); break; } } } } while (0)

struct XcdBarrier {
    unsigned* bar; unsigned x;
    volatile LAS unsigned* st;
};

__device__ __forceinline__ XcdBarrier xcd_barrier_post(unsigned* bar, volatile LAS unsigned* st) {
    XcdBarrier b; b.bar = bar; b.x = xb_xcc_id(); b.st = st;
    if (threadIdx.x == 0) (void)xb_add(&bar[XB_XCNT(b.x)], 1u);
    return b;
}
__device__ __forceinline__ void xcd_barrier_complete(unsigned* bar, unsigned x, unsigned& nloc, unsigned& nx) {
    const unsigned G = gridDim.x * gridDim.y * gridDim.z;
    unsigned sum, cnt, mine, sp = 0u;
    for (;;) {
        sum = 0u; cnt = 0u; mine = 0u;
#pragma unroll
        for (unsigned j = 0; j < 16; ++j) { const unsigned c = xb_ld(&bar[XB_XCNT(j)]); sum += c; cnt += (c > 0u) ? 1u : 0u; mine = (j == x) ? c : mine; }
        if (sum == G) break;
        __builtin_amdgcn_s_sleep(1);
        if ((++sp & 255u) == 0u) { if (xb_ld(&bar[XB_TMO])) break; if (sp > XB_SPIN_CAP) { atomicAdd(&bar[XB_TMO], 1u); break; } }
    }
    nloc = mine > 0u ? mine : 1u; nx = cnt > 0u ? cnt : 1u;
}

__device__ __forceinline__ void xcd_barrier(const XcdBarrier& b) {
    asm volatile("s_waitcnt vmcnt(0)" ::: "memory");
    __syncthreads();
    if (threadIdx.x == 0) {
        unsigned* bar = b.bar;
        __builtin_amdgcn_s_waitcnt(0);
        unsigned nloc = b.st[0], nx = b.st[1];
        if (nloc == 0u) { xcd_barrier_complete(bar, b.x, nloc, nx); b.st[0] = nloc; b.st[1] = nx; }
        const unsigned old = xb_add(&bar[XB_XSUB(b.x)], 1u);
        const unsigned gen = old / nloc;
        if (old + 1u == (gen + 1u) * nloc) {
            __builtin_amdgcn_fence(__ATOMIC_RELEASE, "agent");
            asm volatile("s_waitcnt vmcnt(0)" ::: "memory");
            const unsigned og = xb_add(&bar[XB_TOP], 1u);
            const unsigned tg = og / nx;
            if (og + 1u == (tg + 1u) * nx) xb_add(&bar[XB_TOPGEN], 1u);
            else XB_SPIN(xb_ld(&bar[XB_TOPGEN]) == tg, bar);
            __builtin_amdgcn_fence(__ATOMIC_ACQUIRE, "agent");
            xb_add(&bar[XB_XGEN(b.x)], 1u);
            asm volatile("s_waitcnt vmcnt(0)" ::: "memory");
        } else {
            XB_SPIN(xb_ld(&bar[XB_XGEN(b.x)]) == gen, bar);
            __builtin_amdgcn_fence(__ATOMIC_ACQUIRE, "agent");
            asm volatile("s_waitcnt vmcnt(0)" ::: "memory");
        }
    }
    __syncthreads();
}

#define XB_LOC(j) (1024 + 64 * (j))
__device__ __forceinline__ void xcd_local_barrier(const XcdBarrier& b, unsigned* ctl, unsigned k) {
    asm volatile("s_waitcnt vmcnt(0)" ::: "memory");
    __syncthreads();
    if (threadIdx.x == 0) {
        const unsigned nloc = b.st[0]; unsigned* w = ctl + XB_LOC(b.x);
        __hip_atomic_fetch_add(w, 1u, __ATOMIC_RELAXED, __HIP_MEMORY_SCOPE_AGENT);
        const unsigned target = (k + 1u) * nloc;
        XB_SPIN(xb_ld(w) < target, b.bar);
        __builtin_amdgcn_fence(__ATOMIC_ACQUIRE, "agent");
        asm volatile("s_waitcnt vmcnt(0)" ::: "memory");
    }
    __syncthreads();
}
constexpr int NWAVES = 8;
constexpr int BATCH = 4, SEQ = 8192, D = 1024, M = BATCH * SEQ, DEPTH = 4;
constexpr int MIXW = 768, MEMW = 256, HD = 64, NH = 12, NMH = 4, MEMLEN = 256, FF = 2816, NE = 8;
constexpr int NINA = 3 * MIXW + MEMW;
constexpr int NBLK = SEQ / 256;
constexpr int NKV = 2 * MIXW;
constexpr int NMKV = 2 * MEMW;
constexpr int XS_ROWS = 67584;
constexpr float LN_EPS = 1e-5f;
constexpr float ALPHA = 1.681792830507429f;
constexpr float QK_C2 = 0.125f * 1.4426950408889634f;

constexpr size_t MiB = 1u << 20;
constexpr size_t WS_CTL = 0, CTL_ZERO_BYTES = 1 * MiB;
constexpr size_t WS_COS = 1 * MiB, WS_SIN = 2 * MiB;
constexpr size_t WS_KMEAN = 3 * MiB;
constexpr size_t WS_TOPI = 4 * MiB, WS_TOPG = WS_TOPI + 256 * 1024, WS_POS = WS_TOPG + 256 * 1024;
constexpr size_t WS_MEMB = 5 * MiB;
constexpr size_t WS_MEMKV = 7 * MiB;
constexpr size_t WS_WINA = 12 * MiB;
constexpr size_t WS_WQB = 22 * MiB;
constexpr size_t WS_WKV = 26 * MiB;
constexpr size_t WS_WMKV = 29 * MiB;
constexpr size_t WS_WO = 33 * MiB;
constexpr size_t WS_WGUD = 41 * MiB;
constexpr size_t WS_WDD = 63 * MiB;
constexpr size_t WS_WGUM = 74 * MiB;
constexpr size_t WS_WDM = 250 * MiB;
constexpr size_t WS_XB = 338 * MiB;
constexpr size_t WS_KS = 402 * MiB, WS_VS = 450 * MiB;
constexpr size_t WS_XS = 498 * MiB;
constexpr size_t WS_BIG = 630 * MiB;
constexpr size_t WS_PROJ = 1153 * MiB, WS_MIX = 1313 * MiB;
constexpr size_t WS_END = 993 * MiB;
static_assert(WS_XS + (size_t)XS_ROWS * D * 2 <= WS_BIG && WS_BIG + (size_t)XS_ROWS * FF * 2 <= WS_END && WS_PROJ + (size_t)M * 2560 * 2 <= WS_MIX && WS_MIX + (size_t)M * D * 2 <= 1377 * MiB, "ws map");
static_assert(WS_WDM + (size_t)16 * D * FF * 2 <= WS_XB && WS_WGUM + (size_t)16 * 2 * FF * D * 2 <= WS_WDM && WS_WDD + (size_t)2 * D * FF * 2 <= WS_WGUM && WS_WGUD + (size_t)2 * 2 * FF * D * 2 <= WS_WDD, "ws map weights");
constexpr int CW_BAR = 4096;
constexpr int CW_CNT = 8192, CW_CUR = 8192 + 1024;
constexpr int CW_XRANK = 3100;
constexpr int CW_CSU = 100000;
constexpr size_t WS_XQ = WS_XS + 96 * MiB;
constexpr size_t WS_RS = WS_POS + 256 * 1024;
constexpr int YP_ROWS = 2048;
constexpr size_t WS_YP = 1137 * MiB;
constexpr size_t WS_SRS = 11 * MiB;
constexpr size_t WS_CWV = 11 * MiB + 512 * 1024;
__host__ __device__ constexpr int cw_cnt(int ls, int e) { return CW_CNT + (ls * 8 + e) * 64; }
__host__ __device__ constexpr int cw_cur(int ls, int e) { return CW_CUR + (ls * 8 + e) * 64; }

constexpr int RING_OFF = 0, RING_BYTES = 131072;
constexpr int LDSCTL_OFF = RING_BYTES, MISC_OFF = LDSCTL_OFF + 320;
constexpr int LDS_BYTES = 147456;

struct Args { const float* in[18]; float* out; unsigned char* ws; double invf[8]; };
struct Frame {
    LAS unsigned char* lds; volatile LAS unsigned* MISC; unsigned* ctl;
    int wave, vcu, G, gw, NGW, cid, lok;
    unsigned char* ws; float* X; bf16* XB;
};
__device__ __forceinline__ int opaque_lane() { int t = threadIdx.x; asm volatile("" : "+v"(t)); return t & 63; }
template <int CTRL> __device__ __forceinline__ float dpp_f(float v) { return __builtin_bit_cast(float, __builtin_amdgcn_update_dpp(0, __builtin_bit_cast(int, v), CTRL, 0xf, 0xf, true)); }
template <int CTRL> __device__ __forceinline__ int dpp_i(int v) { return __builtin_amdgcn_update_dpp(0, v, CTRL, 0xf, 0xf, true); }
__device__ __forceinline__ float wave_sum(float v) {
    v += dpp_f<0xB1>(v); v += dpp_f<0x4E>(v); v += dpp_f<0x141>(v); v += dpp_f<0x140>(v);
    { auto r = __builtin_amdgcn_permlane16_swap(__float_as_uint(v), __float_as_uint(v), false, false); v = __uint_as_float(r[0]) + __uint_as_float(r[1]); }
    { auto r = __builtin_amdgcn_permlane32_swap(__float_as_uint(v), __float_as_uint(v), false, false); v = __uint_as_float(r[0]) + __uint_as_float(r[1]); }
    return v;
}
__device__ __forceinline__ float wave_max(float v) {
    v = __builtin_fmaxf(v, dpp_f<0xB1>(v)); v = __builtin_fmaxf(v, dpp_f<0x4E>(v)); v = __builtin_fmaxf(v, dpp_f<0x141>(v)); v = __builtin_fmaxf(v, dpp_f<0x140>(v));
    { auto r = __builtin_amdgcn_permlane16_swap(__float_as_uint(v), __float_as_uint(v), false, false); v = __builtin_fmaxf(__uint_as_float(r[0]), __uint_as_float(r[1])); }
    { auto r = __builtin_amdgcn_permlane32_swap(__float_as_uint(v), __float_as_uint(v), false, false); v = __builtin_fmaxf(__uint_as_float(r[0]), __uint_as_float(r[1])); }
    return v;
}
__device__ __forceinline__ int wave_sum_i(int v) {
    v += dpp_i<0xB1>(v); v += dpp_i<0x4E>(v); v += dpp_i<0x141>(v); v += dpp_i<0x140>(v);
    { auto r = __builtin_amdgcn_permlane16_swap((unsigned)v, (unsigned)v, false, false); v = (int)(r[0] + r[1]); }
    { auto r = __builtin_amdgcn_permlane32_swap((unsigned)v, (unsigned)v, false, false); v = (int)(r[0] + r[1]); }
    return v;
}
__device__ __forceinline__ float bflo(unsigned w) { return __uint_as_float(w << 16); }
__device__ __forceinline__ float bfhi(unsigned w) { return __uint_as_float(w & 0xffff0000u); }
__device__ __forceinline__ void unpack8(const v4u w, float (&f)[8]) { f[0] = bflo(w.x); f[1] = bfhi(w.x); f[2] = bflo(w.y); f[3] = bfhi(w.y); f[4] = bflo(w.z); f[5] = bfhi(w.z); f[6] = bflo(w.w); f[7] = bfhi(w.w); }
__device__ __forceinline__ v4u pack8(const float (&f)[8]) { v4u w; w.x = pk2(f[0], f[1]); w.y = pk2(f[2], f[3]); w.z = pk2(f[4], f[5]); w.w = pk2(f[6], f[7]); return w; }

template <int MODE>
__device__ __forceinline__ void p0_transpose_item(const float* W, int K, int N, bf16* WT, LAS float* scr, int item, int lane) {
    const int nblk = N / 32, kb = item / nblk, nb = item % nblk, k0 = 64 * kb, n0 = 32 * nb;
    int d0 = n0;
    if (MODE == 1) { const int f = n0 < FF ? n0 : n0 - FF; d0 = (f >> 7) * 256 + (f & 127) + (n0 < FF ? 0 : 128); }
#pragma unroll 8
    for (int i = 0; i < 32; ++i) { const int kk = 2 * i + (lane >> 5); scr[kk * 33 + (lane & 31)] = W[(size_t)(k0 + kk) * N + n0 + (lane & 31)]; }
    LDS_WAIT(); asm volatile("" ::: "memory");
    const int c = lane & 7;
#pragma unroll
    for (int j = 0; j < 4; ++j) { const int n = (lane >> 3) + 8 * j; const LAS float* s = scr + (8 * c) * 33 + n;
        v4u o; o.x = pk2(s[0 * 33], s[1 * 33]); o.y = pk2(s[2 * 33], s[3 * 33]); o.z = pk2(s[4 * 33], s[5 * 33]); o.w = pk2(s[6 * 33], s[7 * 33]);
        *(v4u*)(WT + (size_t)(d0 + n) * K + k0 + 8 * c) = o; }
    LDS_WAIT(); asm volatile("" ::: "memory");
}
__device__ __forceinline__ void sincos_f64(double a, float& s, float& c) {
    const double kd = __builtin_rint(a * 0.63661977236758134308);
    double r = __builtin_fma(-kd, 1.57079632673412561417e+00, a); r = __builtin_fma(-kd, 6.07710050650619224932e-11, r);
    const int q = ((int)kd) & 3; const double z = r * r;
    const double sp = r + r * z * (-1.66666666666666324348e-01 + z * (8.33333333332248946124e-03 + z * (-1.98412698298579493134e-04 + z * (2.75573137070700676789e-06 + z * (-2.50507602534068634195e-08 + z * 1.58969099521155010221e-10)))));
    const double cp = 1.0 - 0.5 * z + z * z * (4.16666666666666019037e-02 + z * (-1.38888888888741095749e-03 + z * (2.48015872894767294178e-05 + z * (-2.75573143513906633035e-07 + z * (2.08757232129817482790e-09 + z * -1.13596475577881948265e-11)))));
    const float sf = (float)sp, cf = (float)cp;
    s = (q == 0) ? sf : (q == 1) ? cf : (q == 2) ? -sf : -cf;
    c = (q == 0) ? cf : (q == 1) ? -sf : (q == 2) ? -cf : sf;
}
struct StripSrc { const float* W; int N, K, k0; unsigned char* dst; int drow; unsigned* csu; bool valid; };
constexpr int NQG = 18 * 176;
constexpr int NQS = NQG + 2 * 80;
constexpr int NBS = 2 * 32 + 48 + 4 * 16 + 4 * 32 + 2 * 32 * 3 + 16 * 32 * 3;
__device__ __forceinline__ StripSrc strip_src(Frame& F, const Args& args, int s) {
    StripSrc r; r.valid = s < NQS + NBS; r.csu = nullptr; r.W = args.in[3]; r.N = 32; r.K = 1024; r.k0 = 0; r.dst = F.ws; r.drow = 0;
    if (!r.valid) return r;
    if (s >= NQG && s < NQS) { const int q = s - NQG, mi = q / 80, n0 = (q % 80) * 32; r.drow = n0;
        r.W = args.in[3] + (size_t)mi * D * NINA + n0; r.N = NINA; r.K = D; r.k0 = 0; r.dst = F.ws + WS_WINA + (size_t)mi * NINA * D; r.csu = F.ctl + CW_CSU + 18 * 2 * FF + mi * NINA; return r; }
    if (s < NQG) { const int mi = s / 176, n0 = (s % 176) * 32; const int f = n0 < FF ? n0 : n0 - FF; r.drow = (f >> 7) * 256 + (f & 127) + (n0 < FF ? 0 : 128);
        r.W = (mi < 2 ? args.in[13] + (size_t)mi * D * 2 * FF : args.in[16] + (size_t)(mi - 2) * D * 2 * FF) + n0; r.N = 2 * FF; r.K = D; r.k0 = 0;
        r.dst = mi < 2 ? F.ws + WS_WGUD + (size_t)mi * 2 * FF * D : F.ws + WS_WGUM + (size_t)(mi - 2) * 2 * FF * D; r.csu = F.ctl + CW_CSU + mi * 2 * FF; return r; }
    int q = s - NQS;
#define SG(srcp, nmat, KK, NN, dstoff) { constexpr int KP_ = ((KK) + 1023) / 1024, SPM_ = ((NN) / 32) * KP_; if (q < (nmat) * SPM_) { const int mi = q / SPM_, u = q % SPM_, nb = u / KP_, kp = u % KP_; \
        r.W = (srcp) + (size_t)mi * (KK) * (NN) + (size_t)(kp * 1024) * (NN) + nb * 32; r.N = (NN); r.K = (KK); r.k0 = kp * 1024; r.dst = F.ws + (dstoff) + (size_t)mi * (NN) * (KK) * 2; r.drow = nb * 32; return r; } q -= (nmat) * SPM_; }
    SG(args.in[5], 2, D, D, WS_WQB) SG(args.in[6], 1, D, NKV, WS_WKV) SG(args.in[7], 4, D, NMKV, WS_WMKV) SG(args.in[8], 4, D, D, WS_WO)
    SG(args.in[14], 2, FF, D, WS_WDD) SG(args.in[17], 16, FF, D, WS_WDM)
#undef SG
    r.valid = false; return r;
}
__device__ __forceinline__ void strip_load(const StripSrc& S, int t, f32x4 (&v)[16]) {
    const int c4 = t & 7, kg = t >> 3;
    if (S.valid && S.k0 + kg * 16 < S.K) { const float* p = S.W + (size_t)(kg * 16) * S.N + 4 * c4;
#pragma unroll
        for (int j = 0; j < 16; ++j) v[j] = *(const f32x4*)(p + (size_t)j * S.N); }
    else {
#pragma unroll
        for (int j = 0; j < 16; ++j) v[j] = (f32x4){0.f, 0.f, 0.f, 0.f}; }
}
__device__ __forceinline__ void strip_store(Frame& F, const StripSrc& S, int t, const f32x4 (&v)[16]) {
    const int c4 = t & 7, kg = t >> 3; const bool act = S.valid && (S.k0 + kg * 16 < S.K);
    if (S.csu) {
        LAS float* red = (LAS float*)(F.lds + RING_OFF); LAS float* cmax = red + 64 * 32;
        float m4[4] = {0.f, 0.f, 0.f, 0.f};
#pragma unroll
        for (int j = 0; j < 16; ++j)
#pragma unroll
            for (int i = 0; i < 4; ++i) m4[i] = __builtin_fmaxf(m4[i], __builtin_fabsf(v[j][i]));
#pragma unroll
        for (int i = 0; i < 4; ++i) red[kg * 32 + 4 * c4 + i] = m4[i];
        __syncthreads();
        if (t < 32) { float am = 0.f;
#pragma unroll 8
            for (int g = 0; g < 64; ++g) am = __builtin_fmaxf(am, red[g * 32 + t]);
            cmax[t] = am; S.csu[S.drow + t] = __float_as_uint(am); }
        __syncthreads();
#pragma unroll
        for (int i = 0; i < 4; ++i) { const float am = cmax[4 * c4 + i]; const float inv = am > 0.f ? 127.0f / am : 0.f; v4u w;
#pragma unroll
            for (int dw = 0; dw < 4; ++dw) { unsigned x = 0u;
#pragma unroll
                for (int b = 0; b < 4; ++b) x |= ((unsigned)(int)__builtin_rintf(v[dw * 4 + b][i] * inv) & 0xffu) << (8 * b);
                w[dw] = x; }
            *(v4u*)(S.dst + (size_t)(S.drow + 4 * c4 + i) * S.K + S.k0 + kg * 16) = w; }
        __syncthreads();
    } else if (act) {
#pragma unroll
        for (int i = 0; i < 4; ++i) { v4u w0, w1;
            w0.x = pk2(v[0][i], v[1][i]); w0.y = pk2(v[2][i], v[3][i]); w0.z = pk2(v[4][i], v[5][i]); w0.w = pk2(v[6][i], v[7][i]);
            w1.x = pk2(v[8][i], v[9][i]); w1.y = pk2(v[10][i], v[11][i]); w1.z = pk2(v[12][i], v[13][i]); w1.w = pk2(v[14][i], v[15][i]);
            v4u* o = (v4u*)(S.dst + ((size_t)(S.drow + 4 * c4 + i) * S.K + S.k0 + kg * 16) * 2); o[0] = w0; o[1] = w1; }
    }
}
__device__ __forceinline__ void p0_prologue(Frame& F, const Args& args) {
    const int lane = opaque_lane();
    const float* const* in = args.in;
    bf16* ws16 = (bf16*)F.ws;
    {
        const int t = F.wave * 64 + lane; f32x4 va[16], vb[16];
        int s = F.vcu; StripSrc Sa = strip_src(F, args, s), Sb;
        strip_load(Sa, t, va);
        for (; s < NQS + NBS; s += 2 * F.G) {
            Sb = strip_src(F, args, s + F.G); strip_load(Sb, t, vb);
            strip_store(F, Sa, t, va);
            Sa = strip_src(F, args, s + 2 * F.G); strip_load(Sa, t, va);
            if (Sb.valid) strip_store(F, Sb, t, vb);
        }
        __syncthreads();
    }
    (void)ws16;
    const int gt = F.gw * 64 + lane, NT = F.NGW * 64;
    f32x4 na[4][4];
#pragma unroll
    for (int u = 0; u < 4; ++u) { const f32x4* xr = (const f32x4*)(in[0] + (size_t)(F.gw * 4 + u) * D); na[u][0] = xr[2 * lane]; na[u][1] = xr[2 * lane + 1]; na[u][2] = xr[128 + 2 * lane]; na[u][3] = xr[128 + 2 * lane + 1]; }
    for (int row0 = F.gw * 4; row0 < M; row0 += F.NGW * 4) {
        f32x4 a[4][4];
#pragma unroll
        for (int u = 0; u < 4; ++u)
#pragma unroll
            for (int q4 = 0; q4 < 4; ++q4) a[u][q4] = na[u][q4];
        { const int rn = row0 + F.NGW * 4 < M ? row0 + F.NGW * 4 : row0;
#pragma unroll
          for (int u = 0; u < 4; ++u) { const f32x4* xr = (const f32x4*)(in[0] + (size_t)(rn + u) * D); na[u][0] = xr[2 * lane]; na[u][1] = xr[2 * lane + 1]; na[u][2] = xr[128 + 2 * lane]; na[u][3] = xr[128 + 2 * lane + 1]; } }
#pragma unroll
        for (int u = 0; u < 4; ++u) { const int row = row0 + u; float am = 0.f;
#pragma unroll
            for (int q4 = 0; q4 < 4; ++q4)
#pragma unroll
                for (int i = 0; i < 4; ++i) am = __builtin_fmaxf(am, __builtin_fabsf(a[u][q4][i]));
            am = wave_max(am);
            const float inv = am > 0.f ? 127.0f / am : 0.f; unsigned q[4];
#pragma unroll
            for (int q4 = 0; q4 < 4; ++q4) { unsigned x = 0u;
#pragma unroll
                for (int i = 0; i < 4; ++i) x |= ((unsigned)(int)__builtin_rintf(a[u][q4][i] * inv) & 0xffu) << (8 * i);
                q[q4] = x; }
            v4u* xo = (v4u*)(F.XB + (size_t)row * D); v4u w0, w1;
            w0.x = pk2(a[u][0].x, a[u][0].y); w0.y = pk2(a[u][0].z, a[u][0].w); w0.z = pk2(a[u][1].x, a[u][1].y); w0.w = pk2(a[u][1].z, a[u][1].w);
            w1.x = pk2(a[u][2].x, a[u][2].y); w1.y = pk2(a[u][2].z, a[u][2].w); w1.z = pk2(a[u][3].x, a[u][3].y); w1.w = pk2(a[u][3].z, a[u][3].w);
            xo[lane] = w0; xo[64 + lane] = w1;
            unsigned char* xq = F.ws + WS_XQ + (size_t)row * D;
            *(uint2*)(xq + 8 * lane) = make_uint2(q[0], q[1]); *(uint2*)(xq + 512 + 8 * lane) = make_uint2(q[2], q[3]);
            if (lane == 0) ((float*)(F.ws + WS_RS))[row] = am * (1.0f / 127.0f); }
    }
    { const f32x4* x4 = (const f32x4*)in[1]; v4u* o = (v4u*)(F.ws + WS_MEMB);
      for (int i = gt; i < BATCH * MEMLEN * D / 8; i += NT) { const f32x4 a = x4[2 * i], b = x4[2 * i + 1]; v4u w; w.x = pk2(a.x, a.y); w.y = pk2(a.z, a.w); w.z = pk2(b.x, b.y); w.w = pk2(b.z, b.w); o[i] = w; } }
    { const int* pos = (const int*)in[2]; float* cs = (float*)(F.ws + WS_COS); float* sn = (float*)(F.ws + WS_SIN);
      for (int i = gt; i < M * 8; i += NT) { const double a = (double)pos[i >> 3] * args.invf[i & 7]; float s, c; sincos_f64(a, s, c); cs[i] = c; sn[i] = s; } }
}
template <bool ROUTER, bool COMBINE, bool FINAL, bool QUANT = false, bool OWN = false>
__device__ __forceinline__ void ln_phase(Frame& F, const float* gain, const float* bias, const float* wrt, int ls) {
    const int lane = opaque_lane();
    float gv[16], bv[16];
#pragma unroll
    for (int hf = 0; hf < 2; ++hf)
#pragma unroll
        for (int q4 = 0; q4 < 2; ++q4) { const f32x4 g4 = ((const f32x4*)gain)[hf * 128 + lane * 2 + q4], b4 = ((const f32x4*)bias)[hf * 128 + lane * 2 + q4];
#pragma unroll
            for (int i = 0; i < 4; ++i) { gv[hf * 8 + q4 * 4 + i] = g4[i]; bv[hf * 8 + q4 * 4 + i] = b4[i]; } }
    const int* POS = (const int*)(F.ws + WS_POS); const float* TOPG = (const float*)(F.ws + WS_TOPG); const bf16* Y = (const bf16*)(F.ws + WS_XS);
    int* TOPI = (int*)(F.ws + WS_TOPI); float* TOPGw = (float*)(F.ws + WS_TOPG);
    int c0 = 0, c1 = 0, c2 = 0, c3 = 0, c4 = 0, c5 = 0, c6 = 0, c7 = 0;
    f32x4 wr0[16], wr1[16];
    if (ROUTER) {
#pragma unroll
        for (int hf = 0; hf < 2; ++hf)
#pragma unroll
            for (int i = 0; i < 8; ++i) { const int k = hf * 512 + lane * 8 + i; wr0[hf * 8 + i] = ((const f32x4*)wrt)[2 * k]; wr1[hf * 8 + i] = ((const f32x4*)wrt)[2 * k + 1]; } }
    const int step = OWN ? 16 : F.NGW * 2; const int rfirst = OWN ? (F.cid & 7) * (M / 8) + (F.cid >> 3) * (M / 8 / 32) + F.wave * 2 : F.gw * 2; const int rend = OWN ? rfirst + (M / 8 / 32) - F.wave * 2 : M;
    static_assert(!OWN || (M / 8 / 32 == 128 && NWAVES == 8), "OWN row map");
    v4u nx[2][2], nx2[2][2], ny[2][2][2]; int np[2][2], fp[2][2]; float ng[2][2], fg[2][2];
    { const int rb = rfirst;
#pragma unroll
        for (int rr = 0; rr < 2; ++rr) { const v4u* xr = (const v4u*)(F.XB + (size_t)(rb + rr) * D); nx[rr][0] = xr[lane]; nx[rr][1] = xr[64 + lane]; }
        if (!ROUTER) { const int rb2 = rb + step < rend ? rb + step : rb;
#pragma unroll
            for (int rr = 0; rr < 2; ++rr) { const v4u* xr = (const v4u*)(F.XB + (size_t)(rb2 + rr) * D); nx2[rr][0] = xr[lane]; nx2[rr][1] = xr[64 + lane]; } }
        if (COMBINE) { const int rf = rb + step < rend ? rb + step : rb;
#pragma unroll
            for (int rr = 0; rr < 2; ++rr)
#pragma unroll
                for (int k = 0; k < 2; ++k) { np[rr][k] = POS[2 * (rb + rr) + k]; ng[rr][k] = TOPG[2 * (rb + rr) + k]; fp[rr][k] = POS[2 * (rf + rr) + k]; fg[rr][k] = TOPG[2 * (rf + rr) + k]; }
#pragma unroll
            for (int rr = 0; rr < 2; ++rr)
#pragma unroll
                for (int k = 0; k < 2; ++k) { const int pc = np[rr][k] < 2 * M ? np[rr][k] : 2 * M - 1; const v4u* y = (const v4u*)(Y + (size_t)pc * D); ny[rr][k][0] = y[lane]; ny[rr][k][1] = y[64 + lane]; } } }
    for (int rowb = rfirst; rowb < rend; rowb += step) {
        float v[2][16]; v4u cy[2][2][2]; int cp[2][2]; float cg[2][2];
#pragma unroll
        for (int rr = 0; rr < 2; ++rr) { float fa[8], fb[8]; unpack8(nx[rr][0], fa); unpack8(nx[rr][1], fb);
#pragma unroll
            for (int i = 0; i < 8; ++i) { v[rr][i] = fa[i]; v[rr][8 + i] = fb[i]; } }
        if (COMBINE) {
#pragma unroll
            for (int rr = 0; rr < 2; ++rr)
#pragma unroll
                for (int k = 0; k < 2; ++k) { cy[rr][k][0] = ny[rr][k][0]; cy[rr][k][1] = ny[rr][k][1]; cp[rr][k] = np[rr][k]; cg[rr][k] = ng[rr][k]; np[rr][k] = fp[rr][k]; ng[rr][k] = fg[rr][k]; } }
        { const int rn = rowb + step < rend ? rowb + step : rowb;
            const int rn2 = rowb + 2 * step < rend ? rowb + 2 * step : rowb;
#pragma unroll
            for (int rr = 0; rr < 2; ++rr) {
                if (ROUTER) { const v4u* xr = (const v4u*)(F.XB + (size_t)(rn + rr) * D); nx[rr][0] = xr[lane]; nx[rr][1] = xr[64 + lane]; }
                else { nx[rr][0] = nx2[rr][0]; nx[rr][1] = nx2[rr][1]; const v4u* xr = (const v4u*)(F.XB + (size_t)(rn2 + rr) * D); nx2[rr][0] = xr[lane]; nx2[rr][1] = xr[64 + lane]; } }
            if (COMBINE) { const int rf = rn + step < rend ? rn + step : rn;
#pragma unroll
                for (int rr = 0; rr < 2; ++rr)
#pragma unroll
                    for (int k = 0; k < 2; ++k) { const int pc = np[rr][k] < 2 * M ? np[rr][k] : 2 * M - 1; const v4u* y = (const v4u*)(Y + (size_t)pc * D); ny[rr][k][0] = y[lane]; ny[rr][k][1] = y[64 + lane];
                        fp[rr][k] = POS[2 * (rf + rr) + k]; fg[rr][k] = TOPG[2 * (rf + rr) + k]; } } }
        if (COMBINE) {
#pragma unroll
            for (int rr = 0; rr < 2; ++rr) { const int p0 = cp[rr][0], p1 = cp[rr][1]; const float g0 = cg[rr][0], g1 = cg[rr][1];
                float a0[8], a1[8], b0[8], b1[8];
                unpack8(cy[rr][0][0], a0); unpack8(cy[rr][0][1], a1); unpack8(cy[rr][1][0], b0); unpack8(cy[rr][1][1], b1);
                if (p0 >= 2 * M || p1 >= 2 * M) {
                    if (p0 >= 2 * M) { float t0[8], t1[8];
#pragma unroll
                        for (int i = 0; i < 8; ++i) { a0[i] = 0.f; a1[i] = 0.f; }
#pragma unroll
                        for (int sl = 0; sl < 4; ++sl) { const v4u* yp = (const v4u*)((const bf16*)(F.ws + WS_YP) + ((size_t)sl * YP_ROWS + (p0 - 2 * M)) * D); unpack8(yp[lane], t0); unpack8(yp[64 + lane], t1);
#pragma unroll
                            for (int i = 0; i < 8; ++i) { a0[i] += t0[i]; a1[i] += t1[i]; } } }
                    if (p1 >= 2 * M) { float t0[8], t1[8];
#pragma unroll
                        for (int i = 0; i < 8; ++i) { b0[i] = 0.f; b1[i] = 0.f; }
#pragma unroll
                        for (int sl = 0; sl < 4; ++sl) { const v4u* yp = (const v4u*)((const bf16*)(F.ws + WS_YP) + ((size_t)sl * YP_ROWS + (p1 - 2 * M)) * D); unpack8(yp[lane], t0); unpack8(yp[64 + lane], t1);
#pragma unroll
                            for (int i = 0; i < 8; ++i) { b0[i] += t0[i]; b1[i] += t1[i]; } } }
                }
#pragma unroll
                for (int i = 0; i < 8; ++i) { v[rr][i] = v[rr][i] * ALPHA + g0 * a0[i] + g1 * b0[i]; v[rr][8 + i] = v[rr][8 + i] * ALPHA + g0 * a1[i] + g1 * b1[i]; } }
        }
#pragma unroll
        for (int rr = 0; rr < 2; ++rr) { const int row = rowb + rr; float s = 0.f;
#pragma unroll
            for (int i = 0; i < 16; ++i) s += v[rr][i];
            const float mean = wave_sum(s) * (1.f / D); float s2 = 0.f;
#pragma unroll
            for (int i = 0; i < 16; ++i) { v[rr][i] -= mean; s2 += v[rr][i] * v[rr][i]; }
            const float rstd = 1.f / sqrtf(wave_sum(s2) * (1.f / D) + LN_EPS);
#pragma unroll
            for (int i = 0; i < 16; ++i) v[rr][i] = v[rr][i] * rstd * gv[i] + bv[i];
            if (FINAL) { f32x4* o = (f32x4*)(F.X + (size_t)row * D);
                o[lane * 2] = (f32x4){v[rr][0], v[rr][1], v[rr][2], v[rr][3]}; o[lane * 2 + 1] = (f32x4){v[rr][4], v[rr][5], v[rr][6], v[rr][7]};
                o[128 + lane * 2] = (f32x4){v[rr][8], v[rr][9], v[rr][10], v[rr][11]}; o[128 + lane * 2 + 1] = (f32x4){v[rr][12], v[rr][13], v[rr][14], v[rr][15]}; }
            else { v4u* xo = (v4u*)(F.XB + (size_t)row * D); v4u w0, w1;
                w0.x = pk2(v[rr][0], v[rr][1]); w0.y = pk2(v[rr][2], v[rr][3]); w0.z = pk2(v[rr][4], v[rr][5]); w0.w = pk2(v[rr][6], v[rr][7]);
                w1.x = pk2(v[rr][8], v[rr][9]); w1.y = pk2(v[rr][10], v[rr][11]); w1.z = pk2(v[rr][12], v[rr][13]); w1.w = pk2(v[rr][14], v[rr][15]);
                xo[lane] = w0; xo[64 + lane] = w1; }
            if (QUANT) {
                float am = 0.f;
#pragma unroll
                for (int i = 0; i < 16; ++i) am = __builtin_fmaxf(am, __builtin_fabsf(v[rr][i]));
                am = wave_max(am);
                const float inv = am > 0.f ? 127.0f / am : 0.f; unsigned q[4] = {0u, 0u, 0u, 0u};
#pragma unroll
                for (int i = 0; i < 16; ++i) q[i >> 2] |= ((unsigned)(int)__builtin_rintf(v[rr][i] * inv) & 0xffu) << (8 * (i & 3));
                unsigned char* xq = F.ws + WS_XQ + (size_t)row * D;
                *(uint2*)(xq + 8 * lane) = make_uint2(q[0], q[1]); *(uint2*)(xq + 512 + 8 * lane) = make_uint2(q[2], q[3]);
                if (lane == 0) ((float*)(F.ws + WS_RS))[row] = am * (1.0f / 127.0f);
            }
            if (ROUTER) {
                float lg[8];
#pragma unroll
                for (int e = 0; e < 8; ++e) lg[e] = 0.f;
#pragma unroll
                for (int hf = 0; hf < 2; ++hf)
#pragma unroll
                    for (int i = 0; i < 8; ++i) { const f32x4 w0 = wr0[hf * 8 + i], w1 = wr1[hf * 8 + i]; const float xv = v[rr][hf * 8 + i];
                        lg[0] += xv * w0.x; lg[1] += xv * w0.y; lg[2] += xv * w0.z; lg[3] += xv * w0.w; lg[4] += xv * w1.x; lg[5] += xv * w1.y; lg[6] += xv * w1.z; lg[7] += xv * w1.w; }
#pragma unroll
                for (int e = 0; e < 8; ++e) lg[e] = wave_sum(lg[e]);
                int i1 = 0; float l1 = lg[0];
#pragma unroll
                for (int e = 1; e < 8; ++e) if (lg[e] > l1) { l1 = lg[e]; i1 = e; }
                int i2 = -1; float l2 = -INFINITY;
#pragma unroll
                for (int e = 0; e < 8; ++e) if (e != i1 && lg[e] > l2) { l2 = lg[e]; i2 = e; }
                const float ex = __expf(l2 - l1); const float g1 = 1.f / (1.f + ex), g2 = ex * g1;
                if (lane == 0) { TOPI[2 * row] = i1; TOPI[2 * row + 1] = i2; TOPGw[2 * row] = g1; TOPGw[2 * row + 1] = g2; }
                c0 += (i1 == 0) + (i2 == 0); c1 += (i1 == 1) + (i2 == 1); c2 += (i1 == 2) + (i2 == 2); c3 += (i1 == 3) + (i2 == 3);
                c4 += (i1 == 4) + (i2 == 4); c5 += (i1 == 5) + (i2 == 5); c6 += (i1 == 6) + (i2 == 6); c7 += (i1 == 7) + (i2 == 7);
            }
        }
    }
    if (ROUTER) {
        int* CWV = (int*)(F.ws + WS_CWV); int* CB = (int*)(F.ws + WS_CWV) + 8 * 2048 * 2;
        LAS int* lc = (LAS int*)(F.lds + RING_OFF);
        if (F.wave == 0 && lane < 8) lc[lane] = 0;
        __syncthreads();
        if (lane == 0) { int* w = CWV + ((size_t)ls * 2048 + F.gw) * 8; w[0] = c0; w[1] = c1; w[2] = c2; w[3] = c3; w[4] = c4; w[5] = c5; w[6] = c6; w[7] = c7;
            __hip_atomic_fetch_add(lc + 0, c0, __ATOMIC_RELAXED, __HIP_MEMORY_SCOPE_WORKGROUP); __hip_atomic_fetch_add(lc + 1, c1, __ATOMIC_RELAXED, __HIP_MEMORY_SCOPE_WORKGROUP);
            __hip_atomic_fetch_add(lc + 2, c2, __ATOMIC_RELAXED, __HIP_MEMORY_SCOPE_WORKGROUP); __hip_atomic_fetch_add(lc + 3, c3, __ATOMIC_RELAXED, __HIP_MEMORY_SCOPE_WORKGROUP);
            __hip_atomic_fetch_add(lc + 4, c4, __ATOMIC_RELAXED, __HIP_MEMORY_SCOPE_WORKGROUP); __hip_atomic_fetch_add(lc + 5, c5, __ATOMIC_RELAXED, __HIP_MEMORY_SCOPE_WORKGROUP);
            __hip_atomic_fetch_add(lc + 6, c6, __ATOMIC_RELAXED, __HIP_MEMORY_SCOPE_WORKGROUP); __hip_atomic_fetch_add(lc + 7, c7, __ATOMIC_RELAXED, __HIP_MEMORY_SCOPE_WORKGROUP); }
        __syncthreads();
        if (F.wave == 0 && lane < 8) CB[((size_t)ls * 256 + F.vcu) * 8 + lane] = lc[lane];
    }
    if (ROUTER && lane == 0) {
        __hip_atomic_fetch_add(F.ctl + cw_cnt(ls, 0), (unsigned)c0, RLX_AGENT); __hip_atomic_fetch_add(F.ctl + cw_cnt(ls, 1), (unsigned)c1, RLX_AGENT);
        __hip_atomic_fetch_add(F.ctl + cw_cnt(ls, 2), (unsigned)c2, RLX_AGENT); __hip_atomic_fetch_add(F.ctl + cw_cnt(ls, 3), (unsigned)c3, RLX_AGENT);
        __hip_atomic_fetch_add(F.ctl + cw_cnt(ls, 4), (unsigned)c4, RLX_AGENT); __hip_atomic_fetch_add(F.ctl + cw_cnt(ls, 5), (unsigned)c5, RLX_AGENT);
        __hip_atomic_fetch_add(F.ctl + cw_cnt(ls, 6), (unsigned)c6, RLX_AGENT); __hip_atomic_fetch_add(F.ctl + cw_cnt(ls, 7), (unsigned)c7, RLX_AGENT);
    }
}
struct Segs { int ps[9]; };
__device__ __forceinline__ void load_segs(Frame& F, int ls, Segs& sg) {
    sg.ps[0] = 0;
#pragma unroll
    for (int e = 0; e < 8; ++e) { const unsigned c = __builtin_amdgcn_readfirstlane(__hip_atomic_load(F.ctl + cw_cnt(ls, e), RLX_AGENT)); sg.ps[e + 1] = sg.ps[e] + (int)((c + 255u) >> 8); }
}
__device__ __forceinline__ void scatter_phase(Frame& F, int ls) {
    const int lane = opaque_lane();
    v4u a[16];
    if (F.gw < M / 16) {
#pragma unroll
        for (int i = 0; i < 16; ++i) { const int r = (F.cid & 7) * (M / 8) + (F.cid >> 3) * 128 + F.wave * 2 + (i >> 1) * 16 + (i & 1); a[i] = ((const v4u*)(F.ws + WS_XQ + (size_t)r * D))[lane]; } }
    Segs sg; load_segs(F, ls, sg);
    const int* TOPI = (const int*)(F.ws + WS_TOPI); int* POS = (int*)(F.ws + WS_POS); unsigned char* XS = F.ws + WS_XS;
    const int* CWV = (const int*)(F.ws + WS_CWV) + (size_t)ls * 2048 * 8; const int* CB = (const int*)(F.ws + WS_CWV) + 8 * 2048 * 2 + (size_t)ls * 256 * 8;
    int pre[8];
#pragma unroll
    for (int e = 0; e < 8; ++e) pre[e] = 0;
    for (int v = lane; v < F.vcu; v += 64) { const int4 x0 = ((const int4*)(CB + (size_t)v * 8))[0], x1 = ((const int4*)(CB + (size_t)v * 8))[1];
        pre[0] += x0.x; pre[1] += x0.y; pre[2] += x0.z; pre[3] += x0.w; pre[4] += x1.x; pre[5] += x1.y; pre[6] += x1.z; pre[7] += x1.w; }
    if (lane < F.wave) { const int4 x0 = ((const int4*)(CWV + (size_t)(F.vcu * NWAVES + lane) * 8))[0], x1 = ((const int4*)(CWV + (size_t)(F.vcu * NWAVES + lane) * 8))[1];
        pre[0] += x0.x; pre[1] += x0.y; pre[2] += x0.z; pre[3] += x0.w; pre[4] += x1.x; pre[5] += x1.y; pre[6] += x1.z; pre[7] += x1.w; }
#pragma unroll
    for (int e = 0; e < 8; ++e) pre[e] = wave_sum_i(pre[e]) + sg.ps[e] * 256;
    if (F.gw < M / 16) {
        const int row = (F.cid & 7) * (M / 8) + (F.cid >> 3) * 128 + F.wave * 2 + (lane >> 1) * 16 + (lane & 1);
        int posk[2];
#pragma unroll
        for (int k = 0; k < 2; ++k) {
            const int e = (lane < 16) ? TOPI[2 * row + k] : -1; int pos = 0;
#pragma unroll
            for (int ee = 0; ee < 8; ++ee) {
                const unsigned long long mask = __ballot(e == ee);
                if (e == ee) pos = pre[ee] + (int)__popcll(mask & ((1ull << lane) - 1ull));
                pre[ee] += (int)__popcll(mask);
            }
            if (lane < 16) POS[2 * row + k] = pos;
            posk[k] = pos;
        }
        const float myrs = (lane < 16) ? ((const float*)(F.ws + WS_RS))[row] : 0.f;
        if (lane < 16) { ((float*)(F.ws + WS_SRS))[posk[0]] = myrs; ((float*)(F.ws + WS_SRS))[posk[1]] = myrs; }
#pragma unroll
        for (int i = 0; i < 16; ++i)
#pragma unroll
            for (int k = 0; k < 2; ++k) { const int p = __builtin_amdgcn_readlane(posk[k], i); ((v4u*)(XS + (size_t)p * D))[lane] = a[i]; }
    }
}
__device__ __forceinline__ void ropek_phase(Frame& F) {
    const int lane = opaque_lane();
    bf16* KS = (bf16*)(F.ws + WS_KS); const float* COS = (const float*)(F.ws + WS_COS); const float* SIN = (const float*)(F.ws + WS_SIN); float* KMEAN = (float*)(F.ws + WS_KMEAN);
    const int lr = lane >> 3, ch = lane & 7;
    for (int unit = F.gw; unit < BATCH * NH * NBLK; unit += F.NGW) {
        const int b = unit / (NH * NBLK), h = (unit / NBLK) % NH, n = unit % NBLK;
        float sum[8];
#pragma unroll
        for (int i = 0; i < 8; ++i) sum[i] = 0.f;
        for (int it0 = 0; it0 < 32; it0 += 8) {
            v4u wv[8];
#pragma unroll
            for (int j = 0; j < 8; ++j) wv[j] = *(const v4u*)(KS + (size_t)(b * SEQ + n * 256 + (it0 + j) * 8 + lr) * MIXW + h * HD + ch * 8);
#pragma unroll
            for (int j = 0; j < 8; ++j) {
                const int row = b * SEQ + n * 256 + (it0 + j) * 8 + lr; v4u* p = (v4u*)(KS + (size_t)row * MIXW + h * HD + ch * 8);
                float f[8], pf[8]; unpack8(wv[j], f);
#pragma unroll
                for (int i = 0; i < 8; ++i) pf[i] = __shfl_xor(f[i], 1);
                if (ch < 2) {
                    const f32x4 ca = ((const f32x4*)COS)[2 * row], cb = ((const f32x4*)COS)[2 * row + 1], sa = ((const f32x4*)SIN)[2 * row], sb = ((const f32x4*)SIN)[2 * row + 1];
                    const float cs[8] = {ca.x, ca.y, ca.z, ca.w, cb.x, cb.y, cb.z, cb.w}, sn[8] = {sa.x, sa.y, sa.z, sa.w, sb.x, sb.y, sb.z, sb.w};
#pragma unroll
                    for (int i = 0; i < 8; ++i) f[i] = (ch == 0) ? f[i] * cs[i] - pf[i] * sn[i] : f[i] * cs[i] + pf[i] * sn[i];
                    *p = pack8(f);
                }
#pragma unroll
                for (int i = 0; i < 8; ++i) sum[i] += f[i];
            }
        }
#pragma unroll
        for (int i = 0; i < 8; ++i) { float s = sum[i]; s += __shfl_xor(s, 8); s += __shfl_xor(s, 16); s += __shfl_xor(s, 32); sum[i] = s * (1.f / 256.f); }
        if (lane < 8) { float* o = KMEAN + (size_t)unit * HD + ch * 8;
#pragma unroll
            for (int i = 0; i < 8; ++i) o[i] = sum[i]; }
    }
}
__device__ __forceinline__ void conv_phase(Frame& F, const float* cw) {
    const int lane = opaque_lane();
    const bf16* PROJ = (const bf16*)(F.ws + WS_PROJ); bf16* MIX = (bf16*)(F.ws + WS_MIX);
    const int gt = F.gw * 64 + lane, NT = F.NGW * 64;
    for (int item = gt; item < (M / 32) * (MIXW / 8); item += NT) {
        const int chunk = item / (MIXW / 8), cg = item % (MIXW / 8), r0 = chunk * 32, c0 = cg * 8;
        float w0[8], w1[8], w2[8], p2[8], p1[8];
#pragma unroll
        for (int i = 0; i < 8; ++i) { w0[i] = cw[c0 + i]; w1[i] = cw[MIXW + c0 + i]; w2[i] = cw[2 * MIXW + c0 + i]; p2[i] = 0.f; p1[i] = 0.f; }
        if ((r0 & (SEQ - 1)) != 0) {
            float a[8], b[8];
            unpack8(*(const v4u*)(PROJ + (size_t)(r0 - 2) * NINA + MIXW + c0), a); unpack8(*(const v4u*)(PROJ + (size_t)(r0 - 2) * NINA + 2 * MIXW + c0), b);
#pragma unroll
            for (int i = 0; i < 8; ++i) p2[i] = a[i] * b[i];
            unpack8(*(const v4u*)(PROJ + (size_t)(r0 - 1) * NINA + MIXW + c0), a); unpack8(*(const v4u*)(PROJ + (size_t)(r0 - 1) * NINA + 2 * MIXW + c0), b);
#pragma unroll
            for (int i = 0; i < 8; ++i) p1[i] = a[i] * b[i];
        }
        v4u nb[4], nc[4], nh[4];
#pragma unroll
        for (int i4 = 0; i4 < 4; ++i4) { const size_t row = (size_t)(r0 + i4); nb[i4] = *(const v4u*)(PROJ + row * NINA + c0); nc[i4] = *(const v4u*)(PROJ + row * NINA + MIXW + c0); nh[i4] = *(const v4u*)(PROJ + row * NINA + 2 * MIXW + c0); }
        for (int rb = 0; rb < 32; rb += 4) {
            v4u lb[4], lc[4], lh[4];
#pragma unroll
            for (int i4 = 0; i4 < 4; ++i4) { lb[i4] = nb[i4]; lc[i4] = nc[i4]; lh[i4] = nh[i4]; }
            { const int rbn = rb + 4 < 32 ? rb + 4 : rb;
#pragma unroll
              for (int i4 = 0; i4 < 4; ++i4) { const size_t row = (size_t)(r0 + rbn + i4); nb[i4] = *(const v4u*)(PROJ + row * NINA + c0); nc[i4] = *(const v4u*)(PROJ + row * NINA + MIXW + c0); nh[i4] = *(const v4u*)(PROJ + row * NINA + 2 * MIXW + c0); } }
#pragma unroll
            for (int i4 = 0; i4 < 4; ++i4) { const size_t row = (size_t)(r0 + rb + i4); float ub[8], uc[8], uh[8], o[8];
                unpack8(lb[i4], ub); unpack8(lc[i4], uc); unpack8(lh[i4], uh);
#pragma unroll
                for (int i = 0; i < 8; ++i) { const float cu = uc[i] * uh[i]; o[i] = ub[i] * (w0[i] * p2[i] + w1[i] * p1[i] + w2[i] * cu); p2[i] = p1[i]; p1[i] = cu; }
                *(v4u*)(MIX + row * D + c0) = pack8(o); }
        }
    }
}
constexpr size_t WS_LIST = WS_XS;
constexpr size_t WS_PML = WS_XS + 32 * MiB;
constexpr size_t WS_PO = 993 * MiB;
constexpr size_t WS_END2 = 1377 * MiB;
constexpr int LIST_CAP = 7936;
constexpr int CW_QUEUE = 12288, CW_MCNT = 16384, MCNT_WORDS = 32768;
static_assert(WS_PML + (size_t)BATCH * NH * SEQ * 3 * 2 * 4 <= WS_BIG && WS_LIST + (size_t)BATCH * NH * NBLK * LIST_CAP * 2 <= WS_PML && WS_PO + (size_t)BATCH * NH * SEQ * 3 * 64 * 2 <= WS_END2, "ws map (attention)");
static_assert((CW_MCNT + 2 * MCNT_WORDS) * 4 <= (int)CTL_ZERO_BYTES, "ctl map");

__device__ __forceinline__ void select_phase(Frame& F, int lslot) {
    typedef attn_body::bf16 ab;
    const int lane = opaque_lane(), r32 = lane & 31, hi = lane >> 5, tid = F.wave * 64 + lane;
    const ab* Q = (const ab*)(F.ws + WS_PROJ); const float* KMEAN = (const float*)(F.ws + WS_KMEAN);
    unsigned short* LIST = (unsigned short*)(F.ws + WS_LIST); unsigned* CNT = F.ctl + CW_MCNT + lslot * MCNT_WORDS;
    constexpr int MAXU = 6;
    LAS unsigned* lc = (LAS unsigned*)(F.lds + RING_OFF);
    constexpr int NU = BATCH * NH * NBLK; const int per = (NU + F.G - 1) / F.G;
    for (int j0 = 0; j0 < per; j0 += MAXU) {
        for (int i = tid; i < MAXU * 64; i += NWAVES * 64) lc[i] = 0u;
        __syncthreads();
        unsigned pk[MAXU]; unsigned lp[MAXU][3];
#pragma unroll
        for (int j = 0; j < MAXU; ++j) {
            pk[j] = 0u; lp[j][0] = 0u; lp[j][1] = 0u; lp[j][2] = 0u;
            const int lu_ = (F.cid >> 3) * per + j0 + j, pan_ = (F.cid & 7) * 16 + lu_ / NH; const int u = lu_ < 16 * NH ? 0 : NU; const int bh = (pan_ / NBLK) * NH + lu_ % NH, own = pan_ % NBLK, b = bh / NH, h = bh % NH;
            if (j0 + j < per && u < NU && own > 0) {
                const int t = own * 256 + F.wave * 32 + r32;
                const ab* qp = Q + ((size_t)(b * SEQ + t)) * D + h * HD + hi * 8;
                attn_body::bf16x8 qr[4];
#pragma unroll
                for (int d0 = 0; d0 < 4; ++d0) qr[d0] = *reinterpret_cast<const attn_body::bf16x8*>(qp + d0 * 16);
                pk[j] = attn_body::moba_select<true>(qr, KMEAN + (size_t)bh * NBLK * HD, own, r32, hi, KMEAN + (size_t)BATCH * NH * NBLK * HD + (size_t)bh * NBLK * HD);
                const int nv = (int)(pk[j] >> 24);
                if (hi == 0) {
#pragma unroll
                    for (int k = 0; k < 3; ++k) if (k < nv) lp[j][k] = __hip_atomic_fetch_add(lc + j * 64 + ((pk[j] >> (8 * k)) & 0xffu), 1u, __ATOMIC_RELAXED, __HIP_MEMORY_SCOPE_WORKGROUP);
                }
            }
        }
        __syncthreads();
        if (tid < MAXU * 32) { const int j = tid >> 5, n = tid & 31; const int lu_ = (F.cid >> 3) * per + j0 + j, pan_ = (F.cid & 7) * 16 + lu_ / NH; const int u = lu_ < 16 * NH ? 0 : NU; const int bh = (pan_ / NBLK) * NH + lu_ % NH, own = pan_ % NBLK;
            if (j0 + j < per && u < NU && n < own) { const unsigned c = lc[j * 64 + n]; unsigned base = 0u; if (c) base = __hip_atomic_fetch_add(CNT + (bh * NBLK + n) * 16, c, RLX_AGENT); lc[j * 64 + 32 + n] = base; } }
        __syncthreads();
        if (hi == 0) {
#pragma unroll
            for (int j = 0; j < MAXU; ++j) { const int lu_ = (F.cid >> 3) * per + j0 + j, pan_ = (F.cid & 7) * 16 + lu_ / NH; const int u = lu_ < 16 * NH ? 0 : NU; const int bh = (pan_ / NBLK) * NH + lu_ % NH, own = pan_ % NBLK; const int t = own * 256 + F.wave * 32 + r32; const int nv = (int)(pk[j] >> 24);
#pragma unroll
                for (int k = 0; k < 3; ++k) if (k < nv) { const unsigned n = (pk[j] >> (8 * k)) & 0xffu;
                    LIST[(size_t)(bh * NBLK + n) * LIST_CAP + lc[j * 64 + 32 + n] + lp[j][k]] = (unsigned short)(t | (k << 13)); } }
        }
        __syncthreads();
    }
}
template <int LDQ>
__device__ __forceinline__ void gather_phase(Frame& F, char* lds, int lslot, const bf16* qmem, int layer) {
    typedef attn_body::bf16 ab;
    const ab* Q = (const ab*)(F.ws + WS_PROJ); const ab* KS = (const ab*)(F.ws + WS_KS); const ab* VS = (const ab*)(F.ws + WS_VS); ab* MIX = (ab*)(F.ws + WS_MIX);
    const unsigned short* LIST = (const unsigned short*)(F.ws + WS_LIST); unsigned* CNT = F.ctl + CW_MCNT + lslot * MCNT_WORDS;
    const ab* MKV = (const ab*)(F.ws + WS_MEMKV); const ab* qm16 = (const ab*)qmem;
    constexpr int NITEM = BATCH * NH * NBLK, NMEMU = BATCH * NMH * NBLK;
    LAS int* cl = (LAS int*)(F.lds + RING_OFF + 106496);
    static_assert(attn_body::ATTN_LDS_BYTES <= 106496 && 106496 + NITEM * 4 <= RING_BYTES, "lds map (gather)");
    for (int i = threadIdx.x; i < NITEM; i += NWAVES * 64) cl[i] = (int)CNT[i * 16];
    if (threadIdx.x == 0) F.MISC[0] = __hip_atomic_fetch_add(F.ctl + CW_QUEUE + lslot * 64, 1u, RLX_AGENT);
    __syncthreads();
    int item = (int)F.MISC[0];
    __syncthreads();
    for (;;) {
        if (item >= NITEM + NMEMU) break;
        unsigned nxt_item = 0u; if (threadIdx.x == 0) nxt_item = __hip_atomic_fetch_add(F.ctl + CW_QUEUE + lslot * 64, 1u, RLX_AGENT);
        if (item < NITEM) {
            const int n = item / (BATCH * NH), bh = item % (BATCH * NH), b = bh / NH, h = bh % NH;
            const int cnt = (int)__builtin_amdgcn_readfirstlane(cl[bh * NBLK + n]);
            const long krow = (long)b * SEQ + n * 256;
            const unsigned short* L = LIST + (size_t)(bh * NBLK + n) * LIST_CAP; const ab* Qb = Q + (long)b * SEQ * D + h * HD;
            const int lane = opaque_lane(), li = F.wave * 32 + (lane & 31), hi8 = (lane >> 5) * 8;
#define GQ_ENTRY(c0_) ((c0_) < cnt ? (unsigned)L[(c0_) + (li < ((cnt - (c0_)) < 256 ? (cnt - (c0_)) : 256) ? li : 0)] : 0u)
#define GQ_LOAD(e_, q_) do { const ab* p_ = Qb + (long)((e_) & 0x1fffu) * D + hi8; _Pragma("unroll") for (int d0 = 0; d0 < 4; ++d0) (q_)[d0] = *reinterpret_cast<const attn_body::bf16x8*>(p_ + d0 * 16); } while (0)
            attn_body::bf16x8 qc[4], qn[4];
            if (cnt > 0) { const unsigned e0 = GQ_ENTRY(0); GQ_LOAD(e0, qc); }
            unsigned e_nx = GQ_ENTRY(256);
            for (int c0 = 0; c0 < cnt; c0 += 256) {
                if (c0 + 256 < cnt) GQ_LOAD(e_nx, qn);
                const unsigned e_nx2 = GQ_ENTRY(c0 + 512);
                attn_body::AttnX x{L + c0, (cnt - c0) < 256 ? (cnt - c0) : 256, (ab*)(F.ws + WS_PO), (float*)(F.ws + WS_PML), (long)bh * SEQ, 0, c0 > 0 ? 1 : 0, 0, nullptr, nullptr};
                attn_body::attn_unit<8, 2, D, MIXW, D>(0, Qb, KS + krow * MIXW + h * HD, VS + krow * MIXW + h * HD, nullptr, nullptr, lds, x, qc);
#pragma unroll
                for (int d0 = 0; d0 < 4; ++d0) qc[d0] = qn[d0];
                e_nx = e_nx2;
            }
#undef GQ_ENTRY
#undef GQ_LOAD
        } else {
            const int u = item - NITEM, bh = u / NBLK, qb = u % NBLK, b = bh / NMH, hm = bh % NMH; const long qrow = (long)b * SEQ + qb * 256;
            const ab* Kp = MKV + (size_t)(b * MEMLEN) * (DEPTH * NMKV) + layer * NMKV + hm * HD;
            attn_body::AttnX x{nullptr, 0, nullptr, nullptr, 0, 0, 0, 0, nullptr, nullptr};
            attn_body::attn_unit<8, 0, LDQ, DEPTH * NMKV, D>(0, qm16 + qrow * LDQ + hm * HD, Kp, Kp + MEMW, MIX + qrow * D + MIXW + hm * HD, nullptr, lds, x);
        }
        if (threadIdx.x == 0) F.MISC[0] = nxt_item;
        __syncthreads();
        item = (int)F.MISC[0];
        __syncthreads();
    }
}
__device__ __forceinline__ void own_phase(Frame& F, char* lds) {
    typedef attn_body::bf16 ab;
    const ab* Q = (const ab*)(F.ws + WS_PROJ); const ab* KS = (const ab*)(F.ws + WS_KS); const ab* VS = (const ab*)(F.ws + WS_VS); ab* MIX = (ab*)(F.ws + WS_MIX);
    constexpr int NU = BATCH * NH * NBLK; const int per = (NU + F.G - 1) / F.G;
    for (int j = 0; j < per; ++j) {
        const int lu = (F.cid >> 3) * per + j; if (lu >= 16 * NH) break;
        const int panel = (F.cid & 7) * 16 + lu / NH, h = lu % NH, b = panel / NBLK, own = panel % NBLK, bh = b * NH + h; const long qrow = (long)b * SEQ + own * 256;
        const bool hasn = (j + 1 < per) && (lu + 1 < 16 * NH);
        const int lu1 = lu + 1, panel1 = (F.cid & 7) * 16 + lu1 / NH, h1 = lu1 % NH, own1 = panel1 % NBLK; const long krow1 = (long)(panel1 / NBLK) * SEQ + own1 * 256;
        attn_body::AttnX x{nullptr, 0, (ab*)(F.ws + WS_PO), (float*)(F.ws + WS_PML), (long)bh * SEQ, own, 0, j > 0 ? 1 : 0, hasn ? KS + krow1 * MIXW + h1 * HD : nullptr, hasn ? VS + krow1 * MIXW + h1 * HD : nullptr};
        attn_body::attn_unit<8, 3, D, MIXW, D>(0, Q + qrow * D + h * HD, KS + qrow * MIXW + h * HD, VS + qrow * MIXW + h * HD, MIX + qrow * D + h * HD, nullptr, lds, x);
    }
}
template <int LDQ>
__device__ __forceinline__ void memattn_phase(Frame& F, char* lds, const bf16* qbase, int layer) {
    typedef attn_body::bf16 ab;
    const ab* MKV = (const ab*)(F.ws + WS_MEMKV); ab* MIX = (ab*)(F.ws + WS_MIX); const ab* qb16 = (const ab*)qbase;
    constexpr int NU = BATCH * NMH * NBLK; const int per = (NU + F.G - 1) / F.G;
    for (int i = 0; i < per; ++i) {
        const int u = F.vcu * per + i; if (u >= NU) break;
        const int bh = u / NBLK, qb = u % NBLK, b = bh / NMH, hm = bh % NMH; const long qrow = (long)b * SEQ + qb * 256;
        const ab* Kp = MKV + (size_t)(b * MEMLEN) * (DEPTH * NMKV) + layer * NMKV + hm * HD;
        const bool same = (i > 0) && ((u - 1) / NBLK == bh);
        attn_body::AttnX x{nullptr, 0, nullptr, nullptr, 0, 0, same ? 1 : 0, 0, nullptr, nullptr};
        attn_body::attn_unit<8, 0, LDQ, DEPTH * NMKV, D>(0, qb16 + qrow * LDQ + hm * HD, Kp, Kp + MEMW, MIX + qrow * D + MIXW + hm * HD, nullptr, lds, x);
    }
}
#ifndef WGM_UP
#define WGM_UP 4
#endif
#ifndef WGM_DOWN
#define WGM_DOWN 4
#endif
#ifndef WGM_PROJ
#define WGM_PROJ 4
#endif
template <int layer>
__device__ __forceinline__ void layer_body(Frame& F, const Args& args, const XcdBarrier& bar) {
#define GRID_BAR() xcd_barrier(bar)
#define SEAM_BAR(on_, k_) do { if ((on_) && F.lok) xcd_local_barrier(bar, F.ctl, (unsigned)(k_)); else xcd_barrier(bar); } while (0)
    unsigned char* ws = args.ws;
    const pg8::bf16_t* XBc = (const pg8::bf16_t*)(ws + WS_XB);
    pg8::bf16_t* PROJ = (pg8::bf16_t*)(ws + WS_PROJ); pg8::bf16_t* MIXp = (pg8::bf16_t*)(ws + WS_MIX); pg8::bf16_t* HB = (pg8::bf16_t*)(ws + WS_BIG); pg8::bf16_t* XSp = (pg8::bf16_t*)(ws + WS_XS);
    const int cid = F.cid;
        constexpr bool isA = layer < 2, isMoe = (layer & 1) != 0; constexpr int ls = layer >> 1;
        constexpr bool S0 = !isA, S1 = true, S2 = !isMoe, S3 = !isMoe, S4 = !isMoe, S5 = !isMoe || layer == 1;
        constexpr int LB = layer == 0 ? 0 : layer == 1 ? 5 : layer == 2 ? 7 : 13;
        constexpr bool SP = layer == 3;
        constexpr int KP = LB, K0 = LB + (SP ? 1 : 0), K1 = K0 + (S0 ? 1 : 0), K2 = K1 + (S1 ? 1 : 0), K3 = K2 + (S2 ? 1 : 0), K4 = K3 + (S3 ? 1 : 0), K5 = K4 + (S4 ? 1 : 0);
        if constexpr (isA) {
            pg8::Gemm g{(const pg8::bf16_t*)(ws + WS_XQ), (const pg8::bf16_t*)(ws + WS_WINA + (size_t)layer * NINA * D), M, NINA, D / 2, D / 2, 0}; pg8::PanelOrder S; S.init(M / 256, NINA / 256, F.G, cid);
            pg8::EpiQ8 E{PROJ, NINA, 9, QK_C2, (const float*)(ws + WS_RS), F.ctl + CW_CSU + 18 * 2 * FF + layer * NINA};
            S.wgm = WGM_PROJ;
            pg8::gemm_phase<pg8::EpiQ8, pg8::PanelOrder, true, true, true>(F.lds + RING_OFF, g, S, E);
        } else {
            pg8::Gemm g{XBc, (const pg8::bf16_t*)(ws + WS_WQB) + (size_t)(layer - 2) * D * D, M, D, D, D, 0}; pg8::PanelOrder S; S.init(M / 256, D / 256, F.G, cid);
            pg8::EpiQ<false> E{PROJ, D, 3, 3, (const float*)(ws + WS_COS), (const float*)(ws + WS_SIN), QK_C2, nullptr, nullptr};
            pg8::gemm_phase<pg8::EpiQ<false>, pg8::PanelOrder, true, true>(F.lds + RING_OFF, g, S, E);
        }
        if constexpr (layer == 0) {
            pg8::Gemm g{(const pg8::bf16_t*)(ws + WS_MEMB), (const pg8::bf16_t*)(ws + WS_WMKV), BATCH * MEMLEN, DEPTH * NMKV, D, D, 0}; pg8::PanelOrder S; S.init(BATCH * MEMLEN / 256, DEPTH * NMKV / 256, F.G, cid);
            pg8::EpiBf16 E{(pg8::bf16_t*)(ws + WS_MEMKV), DEPTH * NMKV, 0, 0, 0, 0};
            pg8::gemm_phase<pg8::EpiBf16, pg8::PanelOrder, true, true>(F.lds + RING_OFF, g, S, E);
        }
        SEAM_BAR(SP, KP);
        if constexpr (isA) { conv_phase(F, args.in[4] + (size_t)layer * 3 * MIXW); memattn_phase<NINA>(F, (char*)F.lds + RING_OFF, (const bf16*)(ws + WS_PROJ) + 3 * MIXW, layer); }
        else     { select_phase(F, layer - 2); GRID_BAR();
                   gather_phase<D>(F, (char*)F.lds + RING_OFF, layer - 2, (const bf16*)(ws + WS_PROJ) + MIXW, layer); GRID_BAR();
                   own_phase(F, (char*)F.lds + RING_OFF); }
        SEAM_BAR(S0, K0);
        {
            pg8::Gemm g{MIXp, (const pg8::bf16_t*)(ws + WS_WO) + (size_t)layer * D * D, M, D, D, D, 0}; pg8::PanelOrder S; S.init(M / 256, D / 256, F.G, cid);
            pg8::EpiRes E{(pg8::bf16_t*)(ws + WS_XB), D, ALPHA};
            pg8::gemm_phase<pg8::EpiRes, pg8::PanelOrder, true, true>(F.lds + RING_OFF, g, S, E);
        }
        SEAM_BAR(S1, K1);
        if constexpr (isMoe) ln_phase<true, false, false, true, true>(F, args.in[9] + layer * D, args.in[10] + layer * D, args.in[15] + (size_t)ls * D * NE, ls);
        else       ln_phase<false, false, false, true, true>(F, args.in[9] + layer * D, args.in[10] + layer * D, nullptr, 0);
        SEAM_BAR(S2, K2);
        if constexpr (isMoe) { scatter_phase(F, ls); GRID_BAR(); }
        {
            pg8::PanelOrder S; pg8::EpiGluQ E{HB, FF, nullptr, nullptr, 0x7fffffff, 0x7fffffff, 0x7fffffff, 0x7fffffff, 0x7fffffff, 0x7fffffff, 0x7fffffff, 0};
            const unsigned char* A8; const unsigned char* B8;
            if constexpr (isMoe) { Segs sg; load_segs(F, ls, sg); S.init(sg.ps[8], 2 * FF / 256, F.G, cid);
                S.ps1 = sg.ps[1]; S.ps2 = sg.ps[2]; S.ps3 = sg.ps[3]; S.ps4 = sg.ps[4]; S.ps5 = sg.ps[5]; S.ps6 = sg.ps[6]; S.ps7 = sg.ps[7]; S.estride = (size_t)2 * FF * D;
                E.ps1 = sg.ps[1]; E.ps2 = sg.ps[2]; E.ps3 = sg.ps[3]; E.ps4 = sg.ps[4]; E.ps5 = sg.ps[5]; E.ps6 = sg.ps[6]; E.ps7 = sg.ps[7]; E.cs_estride = 2 * FF;
                E.rs = (const float*)(ws + WS_SRS); E.csu = F.ctl + CW_CSU + (2 + ls * NE) * 2 * FF;
                A8 = ws + WS_XS; B8 = ws + WS_WGUM + (size_t)ls * NE * 2 * FF * D; }
            else { S.init(M / 256, 2 * FF / 256, F.G, cid); E.rs = (const float*)(ws + WS_RS); E.csu = F.ctl + CW_CSU + ls * 2 * FF;
                A8 = ws + WS_XQ; B8 = ws + WS_WGUD + (size_t)ls * 2 * FF * D; }
            pg8::Gemm g{(const pg8::bf16_t*)A8, (const pg8::bf16_t*)B8, M, 2 * FF, D / 2, D / 2, 0};
            S.wgm = WGM_UP;
            pg8::gemm_phase<pg8::EpiGluQ, pg8::PanelOrder, true, true, true>(F.lds + RING_OFF, g, S, E);
        }
        SEAM_BAR(S3, K3);
        if constexpr (isMoe) {
            Segs sg; load_segs(F, ls, sg); const pg8::bf16_t* Wd = (const pg8::bf16_t*)(ws + WS_WDM) + (size_t)ls * NE * D * FF;
            { pg8::PanelOrder S; S.init(256, D / 256, F.G, cid);
              S.ps1 = sg.ps[1]; S.ps2 = sg.ps[2]; S.ps3 = sg.ps[3]; S.ps4 = sg.ps[4]; S.ps5 = sg.ps[5]; S.ps6 = sg.ps[6]; S.ps7 = sg.ps[7]; S.estride = (size_t)D * FF * 2;
              S.wgm = WGM_DOWN;
              pg8::Gemm g{HB, Wd, M, D, FF, FF, 0};
              pg8::EpiBf16 E{XSp, D, 0, 0, 0, 0};
              pg8::gemm_phase<pg8::EpiBf16, pg8::PanelOrder, true, true>(F.lds + RING_OFF, g, S, E); }
            { pg8::PanelOrder S; S.init(sg.ps[8] - 256, (D / 256) * 2, F.G, cid); S.pm0 = 256; S.nNr = D / 256;
              S.ps1 = sg.ps[1]; S.ps2 = sg.ps[2]; S.ps3 = sg.ps[3]; S.ps4 = sg.ps[4]; S.ps5 = sg.ps[5]; S.ps6 = sg.ps[6]; S.ps7 = sg.ps[7]; S.estride = (size_t)D * FF * 2;
              pg8::Gemm g{HB, Wd, M, D, 640, FF, (size_t)640 * 2};
              pg8::EpiBf16 E{(pg8::bf16_t*)(ws + WS_YP), D, 0, 0, 2 * M, (size_t)YP_ROWS * D};
              pg8::gemm_phase<pg8::EpiBf16, pg8::PanelOrder, true, true>(F.lds + RING_OFF, g, S, E); }
            { pg8::PanelOrder S; S.init(sg.ps[8] - 256, (D / 256) * 2, F.G, (cid + 128) % F.G); S.pm0 = 256; S.nNr = D / 256;
              S.ps1 = sg.ps[1]; S.ps2 = sg.ps[2]; S.ps3 = sg.ps[3]; S.ps4 = sg.ps[4]; S.ps5 = sg.ps[5]; S.ps6 = sg.ps[6]; S.ps7 = sg.ps[7]; S.estride = (size_t)D * FF * 2;
              pg8::Gemm g{HB + 1280, Wd + 1280, M, D, 768, FF, (size_t)768 * 2};
              pg8::EpiBf16 E{(pg8::bf16_t*)(ws + WS_YP) + (size_t)2 * YP_ROWS * D, D, 0, 0, 2 * M, (size_t)YP_ROWS * D};
              pg8::gemm_phase<pg8::EpiBf16, pg8::PanelOrder, true, true>(F.lds + RING_OFF, g, S, E); }
        } else {
            pg8::PanelOrder S; S.init(M / 256, D / 256, F.G, cid);
            S.wgm = WGM_DOWN;
            pg8::Gemm g{HB, (const pg8::bf16_t*)(ws + WS_WDD) + (size_t)ls * D * FF, M, D, FF, FF, 0};
            pg8::EpiRes E{(pg8::bf16_t*)(ws + WS_XB), D, ALPHA};
            pg8::gemm_phase<pg8::EpiRes, pg8::PanelOrder, true, true>(F.lds + RING_OFF, g, S, E);
        }
        SEAM_BAR(S4, K4);
        if constexpr (isMoe) ln_phase<false, true, layer == DEPTH - 1, false, layer == 1>(F, args.in[11] + layer * D, args.in[12] + layer * D, nullptr, 0);
        else       ln_phase<false, false, layer == DEPTH - 1, layer == 0, true>(F, args.in[11] + layer * D, args.in[12] + layer * D, nullptr, 0);
        if constexpr (layer == DEPTH - 1) return;
        SEAM_BAR(S5, K5);
        if constexpr (layer == 1) {
            pg8::Gemm g{XBc, (const pg8::bf16_t*)(ws + WS_WKV), M, NKV, D, D, 0}; pg8::PanelOrder S; S.init(M / 256, NKV / 256, F.G, cid);
            pg8::EpiKV E{(pg8::bf16_t*)(ws + WS_KS), (pg8::bf16_t*)(ws + WS_VS), (const float*)(ws + WS_COS), (const float*)(ws + WS_SIN), (float*)(ws + WS_KMEAN)};
            pg8::gemm_phase<pg8::EpiKV, pg8::PanelOrder, true, true>(F.lds + RING_OFF, g, S, E);
        }

}
#undef GRID_BAR
#undef SEAM_BAR
__global__ void __launch_bounds__(NWAVES * 64, 2) mega_fwd(Args args) {
    extern __shared__ __attribute__((aligned(16))) unsigned char lds[];
    Frame F;
    F.lds = (LAS unsigned char*)lds; F.MISC = (volatile LAS unsigned*)(F.lds + MISC_OFF);
    F.wave = __builtin_amdgcn_readfirstlane((int)threadIdx.x >> 6);
    F.G = gridDim.x; { const int bx = blockIdx.x; F.vcu = (F.G % 8 == 0) ? (bx % 8) * (F.G / 8) + bx / 8 : bx; }
    F.gw = F.vcu * NWAVES + F.wave; F.NGW = F.G * NWAVES;
    F.ws = args.ws; F.ctl = (unsigned*)(args.ws + WS_CTL); F.X = args.out; F.XB = (bf16*)(args.ws + WS_XB);
    for (int u = threadIdx.x; u < (LDS_BYTES - LDSCTL_OFF) / 4; u += NWAVES * 64) ((LAS unsigned*)(F.lds + LDSCTL_OFF))[u] = 0u;
    __syncthreads();
    XcdBarrier bar = xcd_barrier_post(F.ctl + CW_BAR, F.MISC + 8);
    if (threadIdx.x == 0) F.MISC[4] = __hip_atomic_fetch_add(F.ctl + CW_XRANK + (xb_xcc_id() & 15u) * 64, 1u, RLX_AGENT);
#define GRID_BAR() xcd_barrier(bar)

    p0_prologue(F, args);
    GRID_BAR();
    {
        if (threadIdx.x == 0) { const unsigned x = xb_xcc_id() & 15u; unsigned base = 0u;
            for (unsigned j = 0; j < 16u; ++j) { const unsigned cj = __hip_atomic_load(F.ctl + CW_XRANK + j * 64, RLX_AGENT); if (j < x) base += cj; }
            const unsigned v = base + F.MISC[4]; const unsigned per = (unsigned)F.G / 8u;
            F.MISC[5] = ((F.G % 8) == 0 && v < (unsigned)F.G) ? (v % per) * 8u + v / per : (unsigned)blockIdx.x;
            unsigned okc = (F.G == 256) ? 1u : 0u;
            for (unsigned j = 0; j < 16u; ++j) { const unsigned cj = __hip_atomic_load(F.ctl + CW_XRANK + j * 64, RLX_AGENT); if (cj != (j < 8u ? 32u : 0u)) okc = 0u; }
            F.MISC[6] = okc; }
        __syncthreads();
        F.cid = (int)F.MISC[5]; F.lok = (int)F.MISC[6];
        __syncthreads();
    }

    layer_body<0>(F, args, bar);
    layer_body<1>(F, args, bar);
    layer_body<2>(F, args, bar);
    layer_body<3>(F, args, bar);
#undef GRID_BAR
}

extern "C" void kernel_launch(void* const* d_in, const int* in_sizes, int n_in, void* d_out, int out_size, void* d_ws, size_t ws_size, hipStream_t stream) {
    static int grid = 0;
    if (grid == 0) {
        if (n_in != 18 || in_sizes[0] != M * D || out_size != M * D || ws_size < WS_END2) { fprintf(stderr, "kernel_launch: unexpected shapes / workspace (n_in %d, in0 %d, out %d, ws %zu, need %zu); nothing launched\n", n_in, n_in > 0 ? in_sizes[0] : -1, out_size, ws_size, (size_t)WS_END2); grid = -1; return; }
        int dev = 0, cus = 0, per_cu = 0;
        if (hipGetDevice(&dev) != hipSuccess || hipDeviceGetAttribute(&cus, hipDeviceAttributeMultiprocessorCount, dev) != hipSuccess) { grid = -1; return; }
        if (hipFuncSetAttribute((const void*)mega_fwd, hipFuncAttributeMaxDynamicSharedMemorySize, LDS_BYTES) != hipSuccess) { fprintf(stderr, "kernel_launch: hipFuncSetAttribute failed\n"); grid = -1; return; }
        if (hipOccupancyMaxActiveBlocksPerMultiprocessor(&per_cu, (const void*)mega_fwd, NWAVES * 64, LDS_BYTES) != hipSuccess || per_cu < 1) { fprintf(stderr, "kernel_launch: occupancy query reports %d workgroups per CU\n", per_cu); }
        (void)hipGetLastError();
        grid = cus;
    }
    if (grid < 0) return;
    if (hipMemsetAsync((char*)d_ws + WS_CTL, 0, CTL_ZERO_BYTES, stream) != hipSuccess) return;
    Args a{};
    for (int i = 0; i < 18; ++i) a.in[i] = (const float*)d_in[i];
    a.out = (float*)d_out; a.ws = (unsigned char*)d_ws;
    for (int i = 0; i < 8; ++i) a.invf[i] = pow(500000.0, -(double)i / 8.0);
    hipLaunchKernelGGL(mega_fwd, dim3(grid), dim3(NWAVES * 64), LDS_BYTES, stream, a);
}
```

```cpp
#include <hip/hip_runtime.h>
#include <cstdio>
#include <cstdint>
#include <cmath>
#include <hip/hip_bf16.h>
__device__ __forceinline__ int sx_lane_() { int l = (int)__builtin_amdgcn_mbcnt_hi(~0u, __builtin_amdgcn_mbcnt_lo(~0u, 0u)); asm volatile("" : "+v"(l)); return l; }
__device__ __forceinline__ int sx_i_(int v, int m) { return __builtin_amdgcn_ds_bpermute((sx_lane_() ^ m) << 2, v); }
__device__ __forceinline__ float my_shfl_xor(float v, int m) { return __builtin_bit_cast(float, sx_i_(__builtin_bit_cast(int, v), m)); }
__device__ __forceinline__ int my_shfl_xor(int v, int m) { return sx_i_(v, m); }
__device__ __forceinline__ unsigned my_shfl_xor(unsigned v, int m) { return (unsigned)sx_i_((int)v, m); }
__device__ __forceinline__ int my_shfl(int v, int src) { return __builtin_amdgcn_ds_bpermute(src << 2, v); }
#define __shfl_xor(v, m) my_shfl_xor((v), (m))
#define __shfl(v, s) my_shfl((v), (s))
namespace pg8 {
#define PG8_LAS __attribute__((address_space(3)))
typedef unsigned short bf16_t;
typedef short bf16x8 __attribute__((ext_vector_type(8)));
typedef float f32x4 __attribute__((ext_vector_type(4)));
typedef unsigned u32x4 __attribute__((ext_vector_type(4)));
constexpr int BM = 256, BK = 64, HALF = 128, HTB = HALF * BK * 2  , STAGE_BYTES = 8 * HTB, NXCD = 8, WGM = 8;

__host__ __device__ __forceinline__ int lds_byte(int r, int c) { const int st = (r >> 4) * 2 + (c >> 5), rr = r & 15, cc = c & 31, ob = rr * 64 + cc * 2; return st * 1024 + (ob ^ (((ob >> 9) & 1) << 5)); }
__host__ __device__ __forceinline__ void stage_rc(int b, int& R, int& C) { const int st = b / 1024, sb = b % 1024, swz = sb ^ (((sb >> 9) & 1) << 5); R = (st >> 1) * 16 + swz / 64; C = (st & 1) * 32 + (swz % 64) / 2; }
__host__ __device__ __forceinline__ int perm32(int rho) { const int n = rho >> 4, i = rho & 15; return 8 * (i >> 2) + 4 * n + (i & 3); }

struct Unit { int pm, pn, part; };
struct Gemm { const bf16_t* A; const bf16_t* Bt; int M, N, K; int ld; size_t kpart; };

struct PanelOrder {
    int nM, nN, nwg, G, c; int ps1, ps2, ps3, ps4, ps5, ps6, ps7; size_t estride; int pm0, nNr, wgm;
    __device__ __forceinline__ void init(int nM_, int nN_, int G_, int c_) { nM = nM_; nN = nN_; nwg = nM * nN; G = G_; c = c_; ps1 = ps2 = ps3 = ps4 = ps5 = ps6 = ps7 = 0x7fffffff; estride = 0; pm0 = 0; nNr = nN_; wgm = 4; }
    __device__ __forceinline__ bool next(int i, Unit& u) const {
        const long L = (long)i * G + c; if (L >= nwg) return false;
        int wgid = (int)L; { const int q = nwg / NXCD, r = nwg % NXCD, xcd = wgid % NXCD, off = wgid / NXCD; wgid = (xcd < r ? xcd * (q + 1) : r * (q + 1) + (xcd - r) * q) + off; }
        const int nig = wgm * nN, gid = wgid / nig, fm = gid * wgm, gsz = (nM - fm) < wgm ? (nM - fm) : wgm;
        u.pm = pm0 + fm + ((wgid % nig) % gsz); const int pnv = (wgid % nig) / gsz; u.part = pnv / nNr; u.pn = pnv - u.part * nNr; return true;
    }
    __device__ __forceinline__ size_t boff(const Unit& u) const {
        const int e = (int)(u.pm >= ps1) + (int)(u.pm >= ps2) + (int)(u.pm >= ps3) + (int)(u.pm >= ps4) + (int)(u.pm >= ps5) + (int)(u.pm >= ps6) + (int)(u.pm >= ps7);
        return (size_t)e * estride;
    }
    __device__ __forceinline__ void a_ready(const Unit&) const {}
    __device__ __forceinline__ void done(const Unit&) const {}
};
__device__ __forceinline__ unsigned cvt_pk_bf16(float lo, float hi) { unsigned r; asm volatile("v_cvt_pk_bf16_f32 %0, %1, %2" : "=v"(r) : "v"(lo), "v"(hi)); return r; }
typedef float f32x2 __attribute__((ext_vector_type(2)));
typedef float f32x2 __attribute__((ext_vector_type(2)));
struct EpiBf16 {
    static constexpr bool PERM = true, AFTER_DRAIN = false, AUX = false;
    bf16_t* O; int ldc; int split_cols; size_t split_stride; int row_off; size_t part_stride;
    __device__ __forceinline__ void operator()(const f32x4 (&acc)[2][2][4][2], const Unit& u, int wr, int wc, int fr, int fq) const {
        const int row0 = u.pm * BM + wr * 64 + fr - row_off; int colt = u.pn * BM; bf16_t* base = O + (size_t)u.part * part_stride;
        if (split_cols) { const int t = colt / split_cols; base += (size_t)t * split_stride; colt -= t * split_cols; }
        const int col0 = colt + wc * 32 + 8 * fq;
#pragma unroll
        for (int ai = 0; ai < 2; ++ai)
#pragma unroll
            for (int m = 0; m < 4; ++m) { bf16_t* rowp = base + (size_t)(row0 + ai * HALF + m * 16) * ldc + col0;
#pragma unroll
                for (int bj = 0; bj < 2; ++bj) { const f32x4 v0 = acc[ai][bj][m][0], v1 = acc[ai][bj][m][1];
                    u32x4 w; w.x = cvt_pk_bf16(v0[0], v0[1]); w.y = cvt_pk_bf16(v0[2], v0[3]); w.z = cvt_pk_bf16(v1[0], v1[1]); w.w = cvt_pk_bf16(v1[2], v1[3]);
                    *(u32x4*)(rowp + bj * HALF) = w; } }
    }
};
__device__ __forceinline__ float silu_mul(float g, float u) { const float e = __builtin_amdgcn_exp2f(g * -1.4426950408889634f); return g * __builtin_amdgcn_rcpf(1.0f + e) * u; }
struct EpiGlu {
    static constexpr bool PERM = true, AFTER_DRAIN = false, AUX = false;
    bf16_t* O; int ldc;
    __device__ __forceinline__ void operator()(const f32x4 (&acc)[2][2][4][2], const Unit& u, int wr, int wc, int fr, int fq) const {
        const int row0 = u.pm * BM + wr * 64 + fr; const int col0 = u.pn * HALF + wc * 32 + 8 * fq;
#pragma unroll
        for (int ai = 0; ai < 2; ++ai)
#pragma unroll
            for (int m = 0; m < 4; ++m) { bf16_t* rowp = O + (size_t)(row0 + ai * HALF + m * 16) * ldc + col0;
                const f32x4 g0 = acc[ai][0][m][0], g1 = acc[ai][0][m][1], u0 = acc[ai][1][m][0], u1 = acc[ai][1][m][1];
                u32x4 w; w.x = cvt_pk_bf16(silu_mul(g0[0], u0[0]), silu_mul(g0[1], u0[1])); w.y = cvt_pk_bf16(silu_mul(g0[2], u0[2]), silu_mul(g0[3], u0[3]));
                w.z = cvt_pk_bf16(silu_mul(g1[0], u1[0]), silu_mul(g1[1], u1[1])); w.w = cvt_pk_bf16(silu_mul(g1[2], u1[2]), silu_mul(g1[3], u1[3]));
                *(u32x4*)rowp = w; }
    }
};
struct EpiGluQ {
    static constexpr bool PERM = true, AFTER_DRAIN = false, AUX = true;
    bf16_t* O; int ldc; const float* rs; const unsigned* csu; int ps1, ps2, ps3, ps4, ps5, ps6, ps7; int cs_estride;
    __device__ __forceinline__ int expert(const Unit& u) const { return (int)(u.pm >= ps1) + (int)(u.pm >= ps2) + (int)(u.pm >= ps3) + (int)(u.pm >= ps4) + (int)(u.pm >= ps5) + (int)(u.pm >= ps6) + (int)(u.pm >= ps7); }
    __device__ __forceinline__ void stage_aux(const Unit& u, PG8_LAS unsigned char* aux, int lane) const {
        __builtin_amdgcn_global_load_lds((const unsigned*)(rs + (size_t)u.pm * BM) + lane * 4, (PG8_LAS unsigned*)aux, 16, 0, 0);
        __builtin_amdgcn_global_load_lds(csu + (size_t)expert(u) * cs_estride + u.pn * BM + lane * 4, (PG8_LAS unsigned*)(aux + 1024), 16, 0, 0);
    }
    __device__ __forceinline__ void operator()(const f32x4 (&acc)[2][2][4][2], const Unit& u, int wr, int wc, int fr, int fq, const PG8_LAS unsigned char* aux) const {
        const int row0 = u.pm * BM + wr * 64 + fr; const int col0 = u.pn * HALF + wc * 32 + 8 * fq;
        const PG8_LAS float* ar = (const PG8_LAS float*)aux + wr * 64 + fr; const PG8_LAS float* ac = (const PG8_LAS float*)(aux + 1024) + wc * 32 + 8 * fq;
        float rsv[8];
#pragma unroll
        for (int i = 0; i < 8; ++i) rsv[i] = ar[(i >> 2) * HALF + (i & 3) * 16];
        f32x2 kg[4], kc[4];
#pragma unroll
        for (int i = 0; i < 4; ++i) { const f32x2 g = {ac[2 * i], ac[2 * i + 1]}, uu = {ac[HALF + 2 * i], ac[HALF + 2 * i + 1]}; kg[i] = g * (-1.4426950408889634f / 127.0f); kc[i] = g * uu * (1.0f / 16129.0f); }
#pragma unroll
        for (int ai = 0; ai < 2; ++ai)
#pragma unroll
            for (int m = 0; m < 4; ++m) { const int row = row0 + ai * HALF + m * 16; bf16_t* rowp = O + (size_t)row * ldc + col0; const float r = rsv[ai * 4 + m]; const f32x2 rr = {r, r};
                f32x2 x[4], y[4], e[4];
#pragma unroll
                for (int p = 0; p < 4; ++p) { const int n = p >> 1, j = (p & 1) * 2;
                    x[p] = (f32x2){(float)__float_as_int(acc[ai][0][m][n][j]), (float)__float_as_int(acc[ai][0][m][n][j + 1])} * rr;
                    y[p] = (f32x2){(float)__float_as_int(acc[ai][1][m][n][j]), (float)__float_as_int(acc[ai][1][m][n][j + 1])} * rr; }
#pragma unroll
                for (int p = 0; p < 4; ++p) e[p] = x[p] * kg[p];
#pragma unroll
                for (int p = 0; p < 4; ++p) { e[p].x = __builtin_amdgcn_exp2f(e[p].x); e[p].y = __builtin_amdgcn_exp2f(e[p].y); }
#pragma unroll
                for (int p = 0; p < 4; ++p) { e[p] = e[p] + (f32x2){1.0f, 1.0f}; x[p] = x[p] * y[p]; }
#pragma unroll
                for (int p = 0; p < 4; ++p) { e[p].x = __builtin_amdgcn_rcpf(e[p].x); e[p].y = __builtin_amdgcn_rcpf(e[p].y); x[p] = x[p] * kc[p]; }
#pragma unroll
                for (int p = 0; p < 4; ++p) x[p] = x[p] * e[p];
                u32x4 w; w.x = cvt_pk_bf16(x[0].x, x[0].y); w.y = cvt_pk_bf16(x[1].x, x[1].y); w.z = cvt_pk_bf16(x[2].x, x[2].y); w.w = cvt_pk_bf16(x[3].x, x[3].y);
                *(u32x4*)rowp = w; }
    }
};
struct EpiRes {
    static constexpr bool PERM = true, AFTER_DRAIN = false, AUX = false;
    bf16_t* X; int ldc; float alpha;
    __device__ __forceinline__ void operator()(const f32x4 (&acc)[2][2][4][2], const Unit& u, int wr, int wc, int fr, int fq) const {
        const int row0 = u.pm * BM + wr * 64 + fr; const int col0 = u.pn * BM + wc * 32 + 8 * fq;
        bf16_t* const base = X + (size_t)row0 * ldc + col0;
        u32x4 b[2][4][2];
#pragma unroll
        for (int ai = 0; ai < 2; ++ai)
#pragma unroll
            for (int m = 0; m < 4; ++m)
#pragma unroll
                for (int bj = 0; bj < 2; ++bj) b[ai][m][bj] = *(const u32x4*)(base + (size_t)(ai * HALF + m * 16) * ldc + bj * HALF);
#pragma unroll
        for (int ai = 0; ai < 2; ++ai)
#pragma unroll
            for (int m = 0; m < 4; ++m)
#pragma unroll
                for (int bj = 0; bj < 2; ++bj) { const u32x4 r = b[ai][m][bj]; const f32x4 v0 = acc[ai][bj][m][0], v1 = acc[ai][bj][m][1];
                    u32x4 w;
                    w.x = cvt_pk_bf16(__uint_as_float(r.x << 16) * alpha + v0[0], __uint_as_float(r.x & 0xffff0000u) * alpha + v0[1]);
                    w.y = cvt_pk_bf16(__uint_as_float(r.y << 16) * alpha + v0[2], __uint_as_float(r.y & 0xffff0000u) * alpha + v0[3]);
                    w.z = cvt_pk_bf16(__uint_as_float(r.z << 16) * alpha + v1[0], __uint_as_float(r.z & 0xffff0000u) * alpha + v1[1]);
                    w.w = cvt_pk_bf16(__uint_as_float(r.w << 16) * alpha + v1[2], __uint_as_float(r.w & 0xffff0000u) * alpha + v1[3]);
                    *(u32x4*)(base + (size_t)(ai * HALF + m * 16) * ldc + bj * HALF) = w; }
    }
};

__device__ __forceinline__ float epi_xor16(float v, bool odd_row) { auto r = __builtin_amdgcn_permlane16_swap(__float_as_uint(v), __float_as_uint(v), false, false); return __uint_as_float(odd_row ? r[0] : r[1]); }
template <int CTRL> __device__ __forceinline__ float epi_dpp(float v) { return __builtin_bit_cast(float, __builtin_amdgcn_update_dpp(0, __builtin_bit_cast(int, v), CTRL, 0xf, 0xf, true)); }
__device__ __forceinline__ float epi_rowsum16(float v) { v += epi_dpp<0xB1>(v); v += epi_dpp<0x4E>(v); v += epi_dpp<0x141>(v); v += epi_dpp<0x140>(v); return v; }
struct EpiKV {
    static constexpr bool PERM = true, AFTER_DRAIN = false, AUX = false;
    bf16_t* KSo; bf16_t* VSo; const float* cs; const float* sn; float* kmp;
    __device__ __forceinline__ void operator()(const f32x4 (&acc)[2][2][4][2], const Unit& u, int wr, int wc, int fr, int fq) const {
        const bool isK = u.pn < 3; const int colt = (isK ? u.pn : u.pn - 3) * BM; bf16_t* base = isK ? KSo : VSo;
        const int row0 = u.pm * BM + wr * 64 + fr; const int col0 = colt + wc * 32 + 8 * fq; const bool first = isK && ((wc & 1) == 0);
        f32x4 cs0[2], cs1[2];
#pragma unroll
        for (int bj = 0; bj < 2; ++bj) { cs0[bj] = (f32x4){0.f, 0.f, 0.f, 0.f}; cs1[bj] = cs0[bj]; }
#pragma unroll
        for (int ai = 0; ai < 2; ++ai)
#pragma unroll
            for (int m = 0; m < 4; ++m) { const int row = row0 + ai * HALF + m * 16; bf16_t* rowp = base + (size_t)row * 768 + col0;
                f32x4 c_lo = {1.f, 1.f, 1.f, 1.f}, c_hi = c_lo, s_lo = {0.f, 0.f, 0.f, 0.f}, s_hi = s_lo;
                if (first) { c_lo = ((const f32x4*)cs)[2 * row]; c_hi = ((const f32x4*)cs)[2 * row + 1]; s_lo = ((const f32x4*)sn)[2 * row]; s_hi = ((const f32x4*)sn)[2 * row + 1]; }
#pragma unroll
                for (int bj = 0; bj < 2; ++bj) { f32x4 v0 = acc[ai][bj][m][0], v1 = acc[ai][bj][m][1];
                    if (first) {
                        f32x4 p0, p1;
#pragma unroll
                        for (int j = 0; j < 4; ++j) { p0[j] = epi_xor16(v0[j], (fq & 1) != 0); p1[j] = epi_xor16(v1[j], (fq & 1) != 0); }
                        if (fq == 0) { v0 = v0 * c_lo - p0 * s_lo; v1 = v1 * c_hi - p1 * s_hi; }
                        else if (fq == 1) { v0 = v0 * c_lo + p0 * s_lo; v1 = v1 * c_hi + p1 * s_hi; }
                    }
                    cs0[bj] += v0; cs1[bj] += v1;
                    u32x4 w; w.x = cvt_pk_bf16(v0[0], v0[1]); w.y = cvt_pk_bf16(v0[2], v0[3]); w.z = cvt_pk_bf16(v1[0], v1[1]); w.w = cvt_pk_bf16(v1[2], v1[3]);
                    *(u32x4*)(rowp + bj * HALF) = w; } }
        if (isK) {
#pragma unroll
            for (int bj = 0; bj < 2; ++bj)
#pragma unroll
                for (int j = 0; j < 4; ++j) { float a = cs0[bj][j], b = cs1[bj][j];
                    a = epi_rowsum16(a); b = epi_rowsum16(b);
                    cs0[bj][j] = a; cs1[bj][j] = b; }
            if (fr == 0) { const int bq = u.pm / 32, n = u.pm % 32;
#pragma unroll
                for (int bj = 0; bj < 2; ++bj) { const int col = colt + bj * HALF + wc * 32 + 8 * fq, head = col >> 6, d = col & 63;
                    float* o = kmp + (((size_t)wr * 48 + bq * 12 + head) * 32 + n) * 64 + d; *(f32x4*)o = cs0[bj]; *(f32x4*)(o + 4) = cs1[bj]; } }
        }
    }
};
struct EpiQ8 {
    static constexpr bool PERM = true, AFTER_DRAIN = false, AUX = true;
    bf16_t* O; int ldc; int scale_from; float c2; const float* rs; const unsigned* csu;
    __device__ __forceinline__ void stage_aux(const Unit& u, PG8_LAS unsigned char* aux, int lane) const {
        __builtin_amdgcn_global_load_lds((const unsigned*)(rs + (size_t)u.pm * BM) + lane * 4, (PG8_LAS unsigned*)aux, 16, 0, 0);
        __builtin_amdgcn_global_load_lds(csu + u.pn * BM + lane * 4, (PG8_LAS unsigned*)(aux + 1024), 16, 0, 0);
    }
    __device__ __forceinline__ void operator()(const f32x4 (&acc)[2][2][4][2], const Unit& u, int wr, int wc, int fr, int fq, const PG8_LAS unsigned char* aux) const {
        const int row0 = u.pm * BM + wr * 64 + fr; const int col0 = u.pn * BM + wc * 32 + 8 * fq;
        const PG8_LAS float* ar = (const PG8_LAS float*)aux + wr * 64 + fr; const PG8_LAS float* ac = (const PG8_LAS float*)(aux + 1024) + wc * 32 + 8 * fq;
        const float sc = (u.pn >= scale_from ? c2 : 1.f) * (1.0f / 127.0f);
        float rsv[8];
#pragma unroll
        for (int i = 0; i < 8; ++i) rsv[i] = ar[(i >> 2) * HALF + (i & 3) * 16];
        f32x2 kq[2][4];
#pragma unroll
        for (int bj = 0; bj < 2; ++bj)
#pragma unroll
            for (int i = 0; i < 4; ++i) kq[bj][i] = (f32x2){ac[bj * HALF + 2 * i], ac[bj * HALF + 2 * i + 1]} * sc;
#pragma unroll
        for (int ai = 0; ai < 2; ++ai)
#pragma unroll
            for (int m = 0; m < 4; ++m) { const int row = row0 + ai * HALF + m * 16; bf16_t* rowp = O + (size_t)row * ldc + col0; const float r = rsv[ai * 4 + m]; const f32x2 rr = {r, r};
#pragma unroll
                for (int bj = 0; bj < 2; ++bj) { f32x2 x[4];
#pragma unroll
                    for (int p = 0; p < 4; ++p) { const int n = p >> 1, j = (p & 1) * 2;
                        x[p] = (f32x2){(float)__float_as_int(acc[ai][bj][m][n][j]), (float)__float_as_int(acc[ai][bj][m][n][j + 1])} * rr * kq[bj][p]; }
                    u32x4 w; w.x = cvt_pk_bf16(x[0].x, x[0].y); w.y = cvt_pk_bf16(x[1].x, x[1].y); w.z = cvt_pk_bf16(x[2].x, x[2].y); w.w = cvt_pk_bf16(x[3].x, x[3].y);
                    *(u32x4*)(rowp + bj * HALF) = w; } }
    }
};
template <bool Q8> struct EpiQ {
    static constexpr bool PERM = true, AFTER_DRAIN = false, AUX = false;
    bf16_t* O; int ldc; int rope_tiles; int scale_from; const float* cs; const float* sn; float c2; const float* rs; const unsigned* csu;
    __device__ __forceinline__ void operator()(const f32x4 (&acc)[2][2][4][2], const Unit& u, int wr, int wc, int fr, int fq) const {
        const int row0 = u.pm * BM + wr * 64 + fr; const int col0 = u.pn * BM + wc * 32 + 8 * fq;
        const bool rope = u.pn < rope_tiles; const float sc = (rope || u.pn >= scale_from) ? c2 : 1.f; const bool first = rope && ((wc & 1) == 0);
        float cq[2][8];
        if (Q8) {
#pragma unroll
            for (int bj = 0; bj < 2; ++bj)
#pragma unroll
                for (int i = 0; i < 8; ++i) cq[bj][i] = __uint_as_float(csu[col0 + bj * HALF + i]) * (1.0f / 127.0f); }
#pragma unroll
        for (int ai = 0; ai < 2; ++ai)
#pragma unroll
            for (int m = 0; m < 4; ++m) { const int row = row0 + ai * HALF + m * 16; bf16_t* rowp = O + (size_t)row * ldc + col0;
                f32x4 c_lo = {1.f, 1.f, 1.f, 1.f}, c_hi = c_lo, s_lo = {0.f, 0.f, 0.f, 0.f}, s_hi = s_lo;
                if (first) { c_lo = ((const f32x4*)cs)[2 * row]; c_hi = ((const f32x4*)cs)[2 * row + 1]; s_lo = ((const f32x4*)sn)[2 * row]; s_hi = ((const f32x4*)sn)[2 * row + 1]; }
#pragma unroll
                for (int bj = 0; bj < 2; ++bj) { f32x4 v0 = acc[ai][bj][m][0], v1 = acc[ai][bj][m][1];
                    if (Q8) { const float r = rs[row];
#pragma unroll
                        for (int j = 0; j < 4; ++j) { v0[j] = (float)__float_as_int(v0[j]) * (r * cq[bj][j]); v1[j] = (float)__float_as_int(v1[j]) * (r * cq[bj][4 + j]); } }
                    if (first) {
                        f32x4 p0, p1;
#pragma unroll
                        for (int j = 0; j < 4; ++j) { p0[j] = epi_xor16(v0[j], (fq & 1) != 0); p1[j] = epi_xor16(v1[j], (fq & 1) != 0); }
                        if (fq == 0) { v0 = v0 * c_lo - p0 * s_lo; v1 = v1 * c_hi - p1 * s_hi; }
                        else if (fq == 1) { v0 = v0 * c_lo + p0 * s_lo; v1 = v1 * c_hi + p1 * s_hi; }
                    }
                    v0 = v0 * sc; v1 = v1 * sc;
                    u32x4 w; w.x = cvt_pk_bf16(v0[0], v0[1]); w.y = cvt_pk_bf16(v0[2], v0[3]); w.z = cvt_pk_bf16(v1[0], v1[1]); w.w = cvt_pk_bf16(v1[2], v1[3]);
                    *(u32x4*)(rowp + bj * HALF) = w; } }
    }
};

typedef int pg8_v4i __attribute__((ext_vector_type(4))); typedef int pg8_v8i __attribute__((ext_vector_type(8)));
__device__ __forceinline__ pg8_v8i pg8_cat(bf16x8 a, bf16x8 b) { const pg8_v4i x = __builtin_bit_cast(pg8_v4i, a), y = __builtin_bit_cast(pg8_v4i, b); return __builtin_shufflevector(x, y, 0, 1, 2, 3, 4, 5, 6, 7); }
template <class Epi, class Sched, bool ALIGN_EPI = false, bool SP2 = false, bool I8 = false>
__device__ __forceinline__ void gemm_phase(PG8_LAS unsigned char* lds, const Gemm g, const Sched& S, const Epi& E) {
    int tid_ = threadIdx.x; asm volatile("" : "+v"(tid_));
    const int tid = tid_, wid = __builtin_amdgcn_readfirstlane(tid >> 6), lane = tid & 63, wr = wid >> 2, wc = wid & 3, fr = lane & 15, fq = lane >> 4;
    const int K = g.ld, nt = g.K / BK;
    unsigned voffA[2], voffB[2];
#pragma unroll
    for (int i = 0; i < 2; ++i) { int R, C; stage_rc(tid * 16 + i * 8192, R, C); const int Rb = Epi::PERM ? ((R & ~31) + perm32(R & 31)) : R;
        voffA[i] = (unsigned)(R * K + C) * 2u; voffB[i] = (unsigned)(Rb * K + C) * 2u; }
    const size_t kstep = (size_t)(BK * 2);
    const size_t hstep = (size_t)HALF * K * 2;
    const size_t tstep = 2 * hstep;
    const unsigned ldsw = (unsigned)wid * 1024u;
    const int aoff = lds_byte(wr * 64 + fr, fq * 8), boff = lds_byte(wc * 32 + fr, fq * 8);
#define PG8_SA(b, h) (((b) * 2 + (h)) * HTB)
#define PG8_SB(b, h) ((4 + (b) * 2 + (h)) * HTB)
#define PG8_STAGE(bufoff, gbase, voff) do { _Pragma("unroll") for (int _i = 0; _i < 2; ++_i) \
        __builtin_amdgcn_global_load_lds((const unsigned*)((const char*)(gbase) + (voff)[_i]), (PG8_LAS unsigned*)(lds + (bufoff) + ldsw + _i * 8192), 16, 0, 0); } while (0)
#define PG8_LD32(base_) __builtin_shufflevector(*(const PG8_LAS pg8_v4i*)(lds + (base_)), *(const PG8_LAS pg8_v4i*)(lds + (base_) + 1024), 0, 1, 2, 3, 4, 5, 6, 7)
#define PG8_LDA(dst, b, h) do { _Pragma("unroll") for (int m = 0; m < 4; ++m) dst[m] = PG8_LD32(PG8_SA(b, h) + aoff + m * 2048); } while (0)
#define PG8_LDB(dst, b, h) do { _Pragma("unroll") for (int n = 0; n < 2; ++n) dst[n] = PG8_LD32(PG8_SB(b, h) + boff + n * 2048); } while (0)
#define PG8_LO(v) __builtin_bit_cast(bf16x8, __builtin_shufflevector(v, v, 0, 1, 2, 3))
#define PG8_HI(v) __builtin_bit_cast(bf16x8, __builtin_shufflevector(v, v, 4, 5, 6, 7))
#define PG8_MMA(ai, bj, At, Bt) do { __builtin_amdgcn_s_setprio(1); \
        if constexpr (I8) { _Pragma("unroll") for (int m = 0; m < 4; ++m) _Pragma("unroll") for (int n = 0; n < 2; ++n) { pg8_v4i c_ = __builtin_bit_cast(pg8_v4i, acc[ai][bj][m][n]); \
            c_ = __builtin_amdgcn_mfma_i32_16x16x64_i8(__builtin_shufflevector(Bt[n], Bt[n], 0, 1, 2, 3), __builtin_shufflevector(At[m], At[m], 0, 1, 2, 3), c_, 0, 0, 0); \
            c_ = __builtin_amdgcn_mfma_i32_16x16x64_i8(__builtin_shufflevector(Bt[n], Bt[n], 4, 5, 6, 7), __builtin_shufflevector(At[m], At[m], 4, 5, 6, 7), c_, 0, 0, 0); \
            acc[ai][bj][m][n] = __builtin_bit_cast(f32x4, c_); } } \
        else { _Pragma("unroll") for (int m = 0; m < 4; ++m) _Pragma("unroll") for (int n = 0; n < 2; ++n) { \
            acc[ai][bj][m][n] = __builtin_amdgcn_mfma_f32_16x16x32_bf16(PG8_LO(Bt[n]), PG8_LO(At[m]), acc[ai][bj][m][n], 0, 0, 0); \
            acc[ai][bj][m][n] = __builtin_amdgcn_mfma_f32_16x16x32_bf16(PG8_HI(Bt[n]), PG8_HI(At[m]), acc[ai][bj][m][n], 0, 0, 0); } } \
        __builtin_amdgcn_s_setprio(0); } while (0)
#define PG8_WAIT_V(n) asm volatile("s_waitcnt vmcnt(" #n ")" ::: "memory")
#define PG8_WAIT_L(n) asm volatile("s_waitcnt lgkmcnt(" #n ")" ::: "memory")
#define PG8_BAR __builtin_amdgcn_s_barrier()
#define PG8_SCHED __builtin_amdgcn_sched_barrier(0)
    Unit cur, nxt; int ui = 0;
    if (!S.next(0, cur)) return;
    f32x4 acc[2][2][4][2];
#pragma unroll
    for (int a = 0; a < 2; ++a)
#pragma unroll
        for (int b = 0; b < 2; ++b)
#pragma unroll
            for (int m = 0; m < 4; ++m)
#pragma unroll
                for (int n = 0; n < 2; ++n) acc[a][b][m][n] = (f32x4){0.f, 0.f, 0.f, 0.f};
    pg8_v8i At[4], B0[2], B1[2];
    const char* cA = (const char*)g.A + (size_t)cur.pm * tstep + (size_t)cur.part * g.kpart; const char* cB = (const char*)g.Bt + S.boff(cur) + (size_t)cur.pn * tstep + (size_t)cur.part * g.kpart;
    S.a_ready(cur);
    if constexpr (Epi::AUX) { if (wid == 0) E.stage_aux(cur, lds + STAGE_BYTES + 1024, lane); }
    if constexpr (SP2) {
        PG8_STAGE(PG8_SB(0, 0), cB, voffB); PG8_STAGE(PG8_SB(0, 1), cB + hstep, voffB); PG8_STAGE(PG8_SA(0, 0), cA, voffA); PG8_STAGE(PG8_SA(0, 1), cA + hstep, voffA);
        if (wr == 1) PG8_BAR;
        PG8_WAIT_V(2); PG8_BAR;
        PG8_STAGE(PG8_SB(1, 0), cB + kstep, voffB); PG8_STAGE(PG8_SA(1, 0), cA + kstep, voffA); PG8_STAGE(PG8_SB(1, 1), cB + hstep + kstep, voffB);
        PG8_WAIT_V(6); PG8_BAR;
    } else {
        PG8_STAGE(PG8_SB(0, 0), cB, voffB); PG8_STAGE(PG8_SA(0, 0), cA, voffA); PG8_STAGE(PG8_SB(0, 1), cB + hstep, voffB); PG8_STAGE(PG8_SA(0, 1), cA + hstep, voffA);
        if (wr == 1) PG8_BAR;
        PG8_WAIT_V(4); PG8_BAR;
        PG8_STAGE(PG8_SB(1, 0), cB + kstep, voffB); PG8_STAGE(PG8_SA(1, 0), cA + kstep, voffA); PG8_STAGE(PG8_SB(1, 1), cB + hstep + kstep, voffB);
        PG8_WAIT_V(6); PG8_BAR;
    }
    for (;;) {
        const bool has_next = S.next(ui + 1, nxt);
        const char* nA = has_next ? (const char*)g.A + (size_t)nxt.pm * tstep + (size_t)nxt.part * g.kpart : cA; const char* nB = has_next ? (const char*)g.Bt + S.boff(nxt) + (size_t)nxt.pn * tstep + (size_t)nxt.part * g.kpart : cB;
#pragma unroll 1
        for (int t = 0; t < nt; t += 2) {
            const bool last = (t == nt - 2);
            const char* a1 = cA + (size_t)(t + 1) * kstep;
            const char* a2 = last ? nA : cA + (size_t)(t + 2) * kstep; const char* b2 = last ? nB : cB + (size_t)(t + 2) * kstep;
            const char* a3 = a2 + kstep; const char* b3 = b2 + kstep;
            if (last && has_next) S.a_ready(nxt);
            if constexpr (SP2) {
            PG8_LDB(B0, 0, 0); PG8_LDB(B1, 0, 1); PG8_SCHED; PG8_LDA(At, 0, 0); PG8_STAGE(PG8_SA(1, 1), a1 + hstep, voffA);
            PG8_WAIT_V(8); PG8_WAIT_L(0); PG8_BAR; PG8_MMA(0, 0, At, B0); PG8_MMA(0, 1, At, B1); PG8_BAR; PG8_SCHED;
            PG8_LDA(At, 0, 1); PG8_STAGE(PG8_SB(0, 0), b2, voffB); PG8_STAGE(PG8_SB(0, 1), b2 + hstep, voffB); PG8_STAGE(PG8_SA(0, 0), a2, voffA);
            PG8_WAIT_V(8); PG8_WAIT_L(0); PG8_BAR; PG8_MMA(1, 0, At, B0); PG8_MMA(1, 1, At, B1); PG8_BAR; PG8_SCHED;
            PG8_LDB(B0, 1, 0); PG8_LDB(B1, 1, 1); PG8_SCHED; PG8_LDA(At, 1, 0); PG8_STAGE(PG8_SA(0, 1), a2 + hstep, voffA);
            PG8_WAIT_V(8); PG8_WAIT_L(0); PG8_BAR; PG8_MMA(0, 0, At, B0); PG8_MMA(0, 1, At, B1); PG8_BAR; PG8_SCHED;
            PG8_LDA(At, 1, 1); PG8_STAGE(PG8_SB(1, 0), b3, voffB); PG8_STAGE(PG8_SB(1, 1), b3 + hstep, voffB); PG8_STAGE(PG8_SA(1, 0), a3, voffA);
            PG8_WAIT_V(8); PG8_WAIT_L(0); PG8_BAR; PG8_MMA(1, 0, At, B0); PG8_MMA(1, 1, At, B1); PG8_BAR; PG8_SCHED;
            } else {
            PG8_LDB(B0, 0, 0); PG8_SCHED; PG8_LDA(At, 0, 0); PG8_STAGE(PG8_SA(1, 1), a1 + hstep, voffA);
            PG8_WAIT_L(8); PG8_BAR; PG8_WAIT_L(0); PG8_MMA(0, 0, At, B0); PG8_BAR; PG8_SCHED;
            PG8_LDB(B1, 0, 1); PG8_STAGE(PG8_SB(0, 0), b2, voffB);
            PG8_BAR; PG8_WAIT_L(0); PG8_MMA(0, 1, At, B1); PG8_BAR;
            PG8_LDA(At, 0, 1); PG8_STAGE(PG8_SA(0, 0), a2, voffA);
            PG8_BAR; PG8_WAIT_L(0); PG8_MMA(1, 0, At, B0); PG8_BAR; PG8_SCHED;
            PG8_STAGE(PG8_SB(0, 1), b2 + hstep, voffB);
            PG8_WAIT_V(6); PG8_BAR; PG8_MMA(1, 1, At, B1); PG8_BAR;
            PG8_LDB(B0, 1, 0); PG8_SCHED; PG8_LDA(At, 1, 0); PG8_STAGE(PG8_SA(0, 1), a2 + hstep, voffA);
            PG8_WAIT_L(8); PG8_BAR; PG8_WAIT_L(0); PG8_MMA(0, 0, At, B0); PG8_BAR; PG8_SCHED;
            PG8_LDB(B1, 1, 1); PG8_STAGE(PG8_SB(1, 0), b3, voffB);
            PG8_BAR; PG8_WAIT_L(0); PG8_MMA(0, 1, At, B1); PG8_BAR;
            PG8_LDA(At, 1, 1); PG8_STAGE(PG8_SA(1, 0), a3, voffA);
            PG8_BAR; PG8_WAIT_L(0); PG8_MMA(1, 0, At, B0); PG8_BAR; PG8_SCHED;
            PG8_STAGE(PG8_SB(1, 1), b3 + hstep, voffB);
            PG8_WAIT_V(6); PG8_BAR; PG8_MMA(1, 1, At, B1); PG8_BAR;
            }
        }
        if constexpr (ALIGN_EPI) { if (wr == 0) PG8_BAR; }
        if constexpr (!Epi::AFTER_DRAIN) { if constexpr (Epi::AUX) { E(acc, cur, wr, wc, fr, fq, lds + STAGE_BYTES + 1024 + (ui & 1) * 2048); if (has_next && wid == 0) { int l_ = threadIdx.x; asm volatile("" : "+v"(l_)); E.stage_aux(nxt, lds + STAGE_BYTES + 1024 + ((ui + 1) & 1) * 2048, l_ & 63); } } else E(acc, cur, wr, wc, fr, fq); S.done(cur); }
        if (!has_next) break;
#pragma unroll
        for (int a = 0; a < 2; ++a)
#pragma unroll
            for (int b = 0; b < 2; ++b)
#pragma unroll
                for (int m = 0; m < 4; ++m)
#pragma unroll
                    for (int n = 0; n < 2; ++n) acc[a][b][m][n] = (f32x4){0.f, 0.f, 0.f, 0.f};
        cur = nxt; cA = nA; cB = nB; ++ui;
        if constexpr (ALIGN_EPI) { if (wr == 1) PG8_BAR; }
    }
    PG8_WAIT_V(0);
    if constexpr (!ALIGN_EPI) { if (wr == 0) PG8_BAR; }
    PG8_BAR;
    if constexpr (Epi::AFTER_DRAIN) { E.fused(acc, cur, wr, wc, fr, fq, lds, wid, lane); S.done(cur); }
#undef PG8_SA
#undef PG8_SB
#undef PG8_STAGE
#undef PG8_LDA
#undef PG8_LDB
#undef PG8_LD32
#undef PG8_LO
#undef PG8_HI
#undef PG8_MMA
#undef PG8_WAIT_V
#undef PG8_WAIT_L
#undef PG8_BAR
#undef PG8_SCHED
}
}

#include <hip/hip_bf16.h>
#include <cmath>
namespace attn_body {
using bf16=__hip_bfloat16;
using bf16x8=__attribute__((ext_vector_type(8)))short;
using s16x4=__attribute__((ext_vector_type(4)))short;
using f32x16=__attribute__((ext_vector_type(16)))float;
using u32x4=__attribute__((ext_vector_type(4)))unsigned;
constexpr int D=64;
constexpr int NW=8,QBLK=32,QB=QBLK*NW,KVBLK=64;
constexpr int ATTN_UNIT_ROWS=QB;
__device__ __forceinline__ int crow(int r,int hi){return (r&3)+8*(r>>2)+4*hi;}
#define SBAR() __builtin_amdgcn_sched_barrier(0)
__device__ __forceinline__ void selmask(f32x16&p0,f32x16&p1,unsigned sel,int n){
  const float lim=((sel>>n)&1u)?INFINITY:-INFINITY;
  #pragma unroll
  for(int r=0;r<16;++r){p0[r]=__builtin_fminf(p0[r],lim);p1[r]=__builtin_fminf(p1[r],lim);}
}
__device__ __forceinline__ void cmask(f32x16&p0,f32x16&p1,int jb,int qrel,int hi){
  const float NEG=-INFINITY; int kb=64*jb+4*hi;
  #pragma unroll
  for(int r=0;r<16;++r){int kv=kb+(r&3)+8*(r>>2); if(kv>qrel)p0[r]=NEG; if(kv+32>qrel)p1[r]=NEG;}
}

constexpr int NSLOT=4, SLOTB=8192;
constexpr int LDS_K=0, LDS_V=NSLOT*SLOTB, LDS_WS=2*NSLOT*SLOTB, LDS_OST=LDS_WS+NW*64*4, LDS_CW=LDS_OST+NW*4096, LDS_BYTES=LDS_CW+NW*512;
constexpr float C2=0.125f*1.4426950408889634f;
__device__ __forceinline__ void glds16(const void*gsrc,unsigned lds_dst){unsigned keep;
  asm volatile("s_mov_b32 %0, m0\n\ts_mov_b32 m0, %2\n\ts_nop 0\n\tglobal_load_lds_dwordx4 %1, off\n\ts_mov_b32 m0, %0":"=&s"(keep):"v"(gsrc),"s"(lds_dst):"memory");}
__device__ __forceinline__ float max3f(float a,float b,float c){float r;asm("v_max3_f32 %0, %1, %2, %3":"=v"(r):"v"(a),"v"(b),"v"(c));return r;}
__device__ __forceinline__ float max2f(float a,float b){float r;asm("v_max_f32_e32 %0, %1, %2":"=v"(r):"v"(a),"v"(b));return r;}
__device__ __forceinline__ float fadd_s(float a,float b){float r;asm("v_add_f32_e32 %0, %1, %2":"=v"(r):"v"(a),"v"(b));return r;}
__device__ __forceinline__ float fsub_s(float a,float b){float r;asm("v_sub_f32_e32 %0, %1, %2":"=v"(r):"v"(a),"v"(b));return r;}
typedef float f32x2_t __attribute__((ext_vector_type(2))); typedef __bf16 bf16x2_t __attribute__((ext_vector_type(2)));
__device__ __forceinline__ unsigned cvtpk_s(float lo,float hi){f32x2_t v={lo,hi};bf16x2_t b=__builtin_convertvector(v,bf16x2_t);return __builtin_bit_cast(unsigned,b);}
#define WAIT_BAR(N) do{ if(ATTN_RESIDENT) asm volatile("s_waitcnt lgkmcnt(0)\n\ts_barrier":::"memory"); else asm volatile("s_waitcnt vmcnt(" #N ") lgkmcnt(0)\n\ts_barrier":::"memory"); }while(0)

__device__ __forceinline__ void qkt(f32x16&p0,f32x16&p1,const char*Kslot,const bf16x8*qr,const f32x16&negm,int r32,int hi){
  const char*kb=Kslot+hi*1024+r32*16;
  #pragma unroll
  for(int d0=0;d0<4;++d0){
    const bf16x8 b0=*reinterpret_cast<const bf16x8*>(kb+d0*2048);
    const bf16x8 b1=*reinterpret_cast<const bf16x8*>(kb+d0*2048+512);
    if(d0==0){p0=__builtin_amdgcn_mfma_f32_32x32x16_bf16(b0,qr[0],negm,0,0,0);p1=__builtin_amdgcn_mfma_f32_32x32x16_bf16(b1,qr[0],negm,0,0,0);}
    else{p0=__builtin_amdgcn_mfma_f32_32x32x16_bf16(b0,qr[d0],p0,0,0,0);p1=__builtin_amdgcn_mfma_f32_32x32x16_bf16(b1,qr[d0],p1,0,0,0);}}
}
typedef __attribute__((address_space(3))) const char* lds_cptr;
typedef short v4i16_t __attribute__((ext_vector_type(4)));
__device__ __forceinline__ void kload8(bf16x8*kf,lds_cptr kp){
  kf[0]=*(const __attribute__((address_space(3))) bf16x8*)(kp);      kf[1]=*(const __attribute__((address_space(3))) bf16x8*)(kp+512);
  kf[2]=*(const __attribute__((address_space(3))) bf16x8*)(kp+2048); kf[3]=*(const __attribute__((address_space(3))) bf16x8*)(kp+2560);
  kf[4]=*(const __attribute__((address_space(3))) bf16x8*)(kp+4096); kf[5]=*(const __attribute__((address_space(3))) bf16x8*)(kp+4608);
  kf[6]=*(const __attribute__((address_space(3))) bf16x8*)(kp+6144); kf[7]=*(const __attribute__((address_space(3))) bf16x8*)(kp+6656);
}
__device__ __forceinline__ void kload2(bf16x8*kf,lds_cptr kp,int j){ kf[2*j]=*(const __attribute__((address_space(3))) bf16x8*)(kp+j*2048); kf[2*j+1]=*(const __attribute__((address_space(3))) bf16x8*)(kp+j*2048+512); }
__device__ __forceinline__ s16x4 vtr(lds_cptr p){ return __builtin_bit_cast(s16x4,__builtin_amdgcn_ds_read_tr16_b64_v4i16((__attribute__((address_space(3))) v4i16_t*)p)); }
__device__ __forceinline__ float rowmax(const f32x16&p0,const f32x16&p1){
  float a=max3f(p0[0],p0[1],p1[0]),b=max3f(p0[2],p0[3],p1[1]);a=max3f(a,p1[2],p1[3]);
  #pragma unroll
  for(int r=4;r<16;r+=4){a=max3f(a,p0[r],p0[r+1]);b=max3f(b,p0[r+2],p0[r+3]);a=max3f(a,p1[r],p1[r+1]);b=max3f(b,p1[r+2],p1[r+3]);}
  const float m=max2f(a,b);
  auto rr=__builtin_amdgcn_permlane32_swap(__float_as_uint(m),__float_as_uint(m),false,false);
  return max2f(__uint_as_float(rr[0]),__uint_as_float(rr[1]));
}
__device__ __forceinline__ void pv(f32x16*o,int vb,bf16x8 pa0,bf16x8 pa1,bf16x8 pa2,bf16x8 pa3){
  #pragma unroll
  for(int d0=0;d0<2;++d0){s16x4 lo[4],hi[4];
    #pragma unroll
    for(int ks=0;ks<4;++ks){
      asm volatile("ds_read_b64_tr_b16 %0,%1 offset:%c2":"=&v"(lo[ks]):"v"(vb),"i"(d0*4096+ks*1024):"memory");
      asm volatile("ds_read_b64_tr_b16 %0,%1 offset:%c2":"=&v"(hi[ks]):"v"(vb),"i"(d0*4096+ks*1024+512):"memory");}
    asm volatile("s_waitcnt lgkmcnt(0)":::"memory");SBAR();
    #define PK(k) (bf16x8){lo[k][0],lo[k][1],lo[k][2],lo[k][3],hi[k][0],hi[k][1],hi[k][2],hi[k][3]}
    o[d0]=__builtin_amdgcn_mfma_f32_32x32x16_bf16(pa0,PK(0),o[d0],0,0,0);
    o[d0]=__builtin_amdgcn_mfma_f32_32x32x16_bf16(pa1,PK(1),o[d0],0,0,0);
    o[d0]=__builtin_amdgcn_mfma_f32_32x32x16_bf16(pa2,PK(2),o[d0],0,0,0);
    o[d0]=__builtin_amdgcn_mfma_f32_32x32x16_bf16(pa3,PK(3),o[d0],0,0,0);
    #undef PK
  }
}


template<bool PICKS=false> __device__ __forceinline__ unsigned moba_select(const bf16x8*qr,const float*kmean,int own,int r32,int hi,const float*kmean2=nullptr){
  f32x16 g=f32x16{};
  #pragma unroll
  for(int d0=0;d0<4;++d0){
    const float*kp=kmean+r32*64+d0*16+hi*8; float4 a=*(const float4*)kp,b=*(const float4*)(kp+4);
    if(kmean2){ const float*kq=kmean2+r32*64+d0*16+hi*8; const float4 a2=*(const float4*)kq,b2=*(const float4*)(kq+4); const float sc_=1.0f/256.0f;
      a.x=(a.x+a2.x)*sc_; a.y=(a.y+a2.y)*sc_; a.z=(a.z+a2.z)*sc_; a.w=(a.w+a2.w)*sc_; b.x=(b.x+b2.x)*sc_; b.y=(b.y+b2.y)*sc_; b.z=(b.z+b2.z)*sc_; b.w=(b.w+b2.w)*sc_; }
    const float x[8]={a.x,a.y,a.z,a.w,b.x,b.y,b.z,b.w}; bf16x8 kh,kl;
    #pragma unroll
    for(int i=0;i<8;++i){ const unsigned u=__float_as_uint(x[i]); const unsigned hb=(u+0x7fffu+((u>>16)&1u))>>16; const float rem=x[i]-__uint_as_float(hb<<16);
      const unsigned v=__float_as_uint(rem); const unsigned lb=(v+0x7fffu+((v>>16)&1u))>>16; kh[i]=(short)hb; kl[i]=(short)lb; }
    g=__builtin_amdgcn_mfma_f32_32x32x16_bf16(kh,qr[d0],g,0,0,0); g=__builtin_amdgcn_mfma_f32_32x32x16_bf16(kl,qr[d0],g,0,0,0);
  }
  float v0=-INFINITY,v1=-INFINITY,v2=-INFINITY; int i0=64,i1=64,i2=64;
  #pragma unroll
  for(int r=0;r<16;++r){ const int n=crow(r,hi); const float x=(n<own)?g[r]:-INFINITY;
    if(x>v0){v2=v1;i2=i1;v1=v0;i1=i0;v0=x;i0=n;} else if(x>v1){v2=v1;i2=i1;v1=x;i1=n;} else if(x>v2){v2=x;i2=n;} }
  float pv[3]; int pi[3];
  pv[0]=__shfl_xor(v0,32); pv[1]=__shfl_xor(v1,32); pv[2]=__shfl_xor(v2,32); pi[0]=__shfl_xor(i0,32); pi[1]=__shfl_xor(i1,32); pi[2]=__shfl_xor(i2,32);
  #pragma unroll
  for(int k=0;k<3;++k){ const float x=pv[k]; const int n=pi[k];
    if(x>v0||(x==v0&&n<i0)){v2=v1;i2=i1;v1=v0;i1=i0;v0=x;i0=n;} else if(x>v1||(x==v1&&n<i1)){v2=v1;i2=i1;v1=x;i1=n;} else if(x>v2||(x==v2&&n<i2)){v2=x;i2=n;} }
  if(PICKS){ const unsigned nv=(v0>-INFINITY?1u:0u)+(v1>-INFINITY?1u:0u)+(v2>-INFINITY?1u:0u); return (unsigned)(i0&0xff)|((unsigned)(i1&0xff)<<8)|((unsigned)(i2&0xff)<<16)|(nv<<24); }
  unsigned sel=0u; if(v0>-INFINITY)sel|=1u<<i0; if(v1>-INFINITY)sel|=1u<<i1; if(v2>-INFINITY)sel|=1u<<i2;
  return sel;
}
#ifndef ATTN_STORE16
#define ATTN_STORE16(p,v) (*(u32x4*)(p)=(v))
#endif
struct AttnX { const unsigned short* list; int nvalid; bf16* part_o; float* part_ml; long bhrow; int own; int resident; int preissued; const bf16* nK; const bf16* nV; };
template<int THRL,int MODE,int QP,int KP,int OP> __device__ __forceinline__ void attn_unit(int qb,const bf16*Qw0,const bf16*__restrict__ Kh,const bf16*__restrict__ Vh,bf16*Ow0,const float*kmean,char*shm,const AttnX x,const bf16x8*qpre=nullptr){
  static_assert(MODE!=1,"MODE 1 needs the three-slot K ring");
  int tid_=threadIdx.x; asm volatile("":"+v"(tid_));
  const int tid=tid_,lane=tid&63,r32=lane&31,hi=lane>>5; const int wid=__builtin_amdgcn_readfirstlane(tid>>6);
  const bf16*Qw=Qw0+(long)(wid*QBLK)*QP;
  constexpr bool MOBA=(MODE==1);
  const bool ATTN_RESIDENT=(x.resident!=0);
  const unsigned lds0=(unsigned)(uintptr_t)shm;
  float*wsf=(float*)(shm+LDS_WS)+wid*64;
  const bf16*ksrc=Kh+(long)lane*KP+wid*8;
  const bf16*vsrc=Vh+(long)(16*(wid&3)+(lane>>2))*KP+(wid>>2)*32+(lane&3)*8;
  const unsigned kdst=lds0+LDS_K+wid*1024, vdst=lds0+LDS_V+wid*1024;
  #define DMA_K(t,slot) do{ if(!x.resident) glds16(ksrc+(long)(t)*KVBLK*KP,(unsigned)__builtin_amdgcn_readfirstlane(kdst+(slot))); }while(0)
  #define DMA_V(t,slot) do{ if(!x.resident) glds16(vsrc+(long)(t)*KVBLK*KP,(unsigned)__builtin_amdgcn_readfirstlane(vdst+(slot))); }while(0)
  const int vb0=(int)(lds0+LDS_V)+((lane>>4)&1)*32+(lane&3)*8+(4*hi+((lane&15)>>2))*64;
  const char*Kbase=shm+LDS_K; bf16x8 kf[8];
  const lds_cptr shm3=(lds_cptr)shm; const lds_cptr kp0=shm3+LDS_K+hi*1024+r32*16; const lds_cptr vp0=shm3+LDS_V+((lane>>4)&1)*32+(lane&3)*8+(4*hi+((lane&15)>>2))*64;
  const int NT=(MODE==1)?4*qb+4:4;
  if(!x.preissued){ DMA_K(0,0);DMA_V(0,0);DMA_K(1,SLOTB); }
  bf16x8 qr[4];
  #pragma unroll
  for(int d0=0;d0<4;++d0){ if(MODE==2&&qpre){ qr[d0]=qpre[d0]; } else if(MODE==2){ const int li=wid*QBLK+r32; const unsigned e=x.list[li<x.nvalid?li:0]; qr[d0]=*reinterpret_cast<const bf16x8*>(&Qw0[(long)(e&0x1fffu)*QP+d0*16+hi*8]); }
    else qr[d0]=*reinterpret_cast<const bf16x8*>(&Qw[(long)r32*QP+d0*16+hi*8]); }
  unsigned sel=0u; if(MOBA) sel=moba_select(qr,kmean,qb,r32,hi);
  unsigned el[4]={0u,0u,0u,0u},eml=0u;
  if(MODE==2){
    #pragma unroll
    for(int i=0;i<4;++i){ const int li=wid*QBLK+i*8+(lane>>3); if(li<x.nvalid) el[i]=x.list[li]; }
    { const int li=wid*QBLK+r32; if(li<x.nvalid) eml=x.list[li]; } }
  float ms3[3]={-INFINITY,-INFINITY,-INFINITY},ls3[3]={0.f,0.f,0.f};
  if(MODE==3){ const float*ml=x.part_ml+((x.bhrow+(long)(x.own*QB+wid*QBLK+r32))*3)*2; const int nsel0=x.own<3?x.own:3;
    #pragma unroll
    for(int s_=0;s_<3;++s_) if(s_<nsel0){ ms3[s_]=ml[2*s_]; ls3[s_]=ml[2*s_+1]; } }
  float mhat=0.f,l_reg=0.f;f32x16 o[2];o[0]=f32x16{};o[1]=f32x16{};f32x16 negm=f32x16{};asm volatile("":"+v"(negm));
  const int qrel=wid*QBLK+r32;
  #define CMASK(P0,P1,t) do{ if(MODE==1||MODE==3){int jb_=(t)-(NT-4); if(jb_>=0)cmask(P0,P1,jb_,qrel,hi); else if(MODE==1)selmask(P0,P1,sel,(t)>>2);} }while(0)
  bool resc=false;
  #define START(P0,P1) do{ const float rm=rowmax(P0,P1); resc=false; \
    { const float dl=MOBA?__builtin_fmaxf(rm,-256.f):rm; mhat=fadd_s(mhat,dl); \
      _Pragma("unroll") for(int r=0;r<16;++r){P0[r]=fsub_s(P0[r],dl);P1[r]=fsub_s(P1[r],dl);} \
      _Pragma("unroll") for(int r=0;r<16;++r)negm[r]=-mhat; asm volatile("":"+v"(negm)); } \
    _Pragma("unroll") for(int r=0;r<16;++r)P0[r]=__builtin_amdgcn_exp2f(P0[r]); }while(0)
  #define RESC() do{ if(resc){ asm volatile("s_waitcnt lgkmcnt(0)":::"memory"); \
      _Pragma("unroll") for(int d_=0;d_<2;++d_) _Pragma("unroll") for(int r=0;r<16;++r)o[d_][r]*=wsf[crow(r,hi)]; } }while(0)
  f32x16 pA0,pA1,pB0,pB1;
  int sl_prev=0,sl_cur=0,sl_next=SLOTB;
  #define ROT() do{sl_prev=sl_cur;sl_cur=sl_next;sl_next=(sl_next==(NSLOT-1)*SLOTB)?0:sl_next+SLOTB;}while(0)
  DMA_K(2,2*SLOTB);
  WAIT_BAR(3);
  qkt(pA0,pA1,Kbase,qr,negm,r32,hi);asm volatile("s_nop 15\n\ts_nop 7":"+v"(pA0),"+v"(pA1));CMASK(pA0,pA1,0);
  START(pA0,pA1);
  _Pragma("unroll") for(int r=0;r<16;++r)pA1[r]=__builtin_amdgcn_exp2f(pA1[r]);
  WAIT_BAR(0);
  DMA_K(3,3*SLOTB);DMA_V(1,SLOTB);
  ROT();
  kload8(kf,kp0+sl_cur);
  WAIT_BAR(2);
  s16x4 vlo[8],vhi[8]; u32x4 pw0,pw1,pw2,pw3;
  #define PKW(P,B) cvtpk_s(P[B],P[B+1])
  #define PAF(k) __builtin_bit_cast(bf16x8,pw##k)
  #define VFR(i) (bf16x8){vlo[i][0],vlo[i][1],vlo[i][2],vlo[i][3],vhi[i][0],vhi[i][1],vhi[i][2],vhi[i][3]}
  #define PIN(x) asm volatile("":"+v"(x))
  #define MX3(a,b,c) __builtin_fmaxf(__builtin_fmaxf((a),(b)),(c))
  #define GAPA(MF,A0,A1,A2,A3,W0,W1,PW) do{ MF; sacc+=A0; sacc+=A1; sacc+=A2; sacc+=A3; PIN(sacc); W0; W1; PIN(PW); SBAR(); }while(0)
  #define EX(v) __builtin_amdgcn_exp2f(v)
  #define GAPB(MF,X,B) do{ MF; X[B]=EX(X[B]); X[B+1]=EX(X[B+1]); X[B+2]=EX(X[B+2]); X[B+3]=EX(X[B+3]); PIN(X); SBAR(); }while(0)
  #define VRD(i) do{ vlo[i]=vtr(vp_+(((i)>>2)*4096+((i)&3)*1024)); vhi[i]=vtr(vp_+(((i)>>2)*4096+((i)&3)*1024+512)); }while(0)
  #define KRD(G,j) do{ if(G){ kload2(kf,kp0+sl_next,j); SBAR(); } }while(0)
  #define STEP(C0,C1,P0,P1,t,GK,GV,GL) do{ SBAR(); \
    const lds_cptr vp_=vp0+sl_prev; \
    VRD(0); SBAR(); float sacc=(P0[0]+P0[1]); \
    GAPA(C0=__builtin_amdgcn_mfma_f32_32x32x16_bf16(kf[0],qr[0],negm,0,0,0), P0[2],P0[3],P0[4],P0[5],     pw0[0]=PKW(P0,0), pw0[1]=PKW(P0,2), pw0); \
    VRD(4); SBAR(); GAPA(C1=__builtin_amdgcn_mfma_f32_32x32x16_bf16(kf[1],qr[0],negm,0,0,0), P0[6],P0[7],P0[8],P0[9],     pw0[2]=PKW(P0,4), pw0[3]=PKW(P0,6), pw0); \
    VRD(1); SBAR(); GAPA(C0=__builtin_amdgcn_mfma_f32_32x32x16_bf16(kf[2],qr[1],C0,0,0,0),   P0[10],P0[11],P0[12],P0[13], pw1[0]=PKW(P0,8), pw1[1]=PKW(P0,10), pw1); \
    VRD(5); SBAR(); GAPA(C1=__builtin_amdgcn_mfma_f32_32x32x16_bf16(kf[3],qr[1],C1,0,0,0),   P0[14],P0[15],P1[0],P1[1],   pw1[2]=PKW(P0,12),pw1[3]=PKW(P0,14), pw1); \
    VRD(2); SBAR(); GAPA(C0=__builtin_amdgcn_mfma_f32_32x32x16_bf16(kf[4],qr[2],C0,0,0,0),   P1[2],P1[3],P1[4],P1[5],     pw2[0]=PKW(P1,0), pw2[1]=PKW(P1,2), pw2); \
    VRD(6); SBAR(); GAPA(C1=__builtin_amdgcn_mfma_f32_32x32x16_bf16(kf[5],qr[2],C1,0,0,0),   P1[6],P1[7],P1[8],P1[9],     pw2[2]=PKW(P1,4), pw2[3]=PKW(P1,6), pw2); \
    VRD(3); SBAR(); GAPA(C0=__builtin_amdgcn_mfma_f32_32x32x16_bf16(kf[6],qr[3],C0,0,0,0),   P1[10],P1[11],P1[12],P1[13], pw3[0]=PKW(P1,8), pw3[1]=PKW(P1,10), pw3); \
    VRD(7); SBAR(); GAPA(C1=__builtin_amdgcn_mfma_f32_32x32x16_bf16(kf[7],qr[3],C1,0,0,0),   P1[14],P1[15],0.f,0.f,       pw3[2]=PKW(P1,12),pw3[3]=PKW(P1,14), pw3); \
    l_reg+=sacc; \
    if(GK){DMA_K((t)+3,sl_cur);} if(GV){DMA_V((t)+1,sl_next);} \
    CMASK(C0,C1,t); \
    { float a=MX3(C0[0],C0[1],C1[0]),b=MX3(C0[2],C0[3],C1[1]); a=MX3(a,C1[2],C1[3]); \
      _Pragma("unroll") for(int r=4;r<16;r+=4){a=MX3(a,C0[r],C0[r+1]);b=MX3(b,C0[r+2],C0[r+3]);a=MX3(a,C1[r],C1[r+1]);b=MX3(b,C1[r+2],C1[r+3]);} \
      float rm=__builtin_fmaxf(a,b); { auto rr=__builtin_amdgcn_permlane32_swap(__float_as_uint(rm),__float_as_uint(rm),false,false); rm=__builtin_fmaxf(__uint_as_float(rr[0]),__uint_as_float(rr[1])); } \
      resc=false; \
      if(__builtin_expect(__any(rm>(float)THRL),0)){ const float dl=(rm>(float)THRL)?rm:0.f;     mhat+=dl; \
        _Pragma("unroll") for(int r=0;r<16;++r){C0[r]-=dl;C1[r]-=dl;} \
        _Pragma("unroll") for(int r=0;r<16;++r)negm[r]=-mhat; asm volatile("":"+v"(negm)); \
        const float f=__builtin_amdgcn_exp2f(-dl); l_reg*=f; if(hi==0)wsf[r32]=f; resc=true; } } \
    SBAR(); \
    GAPB(o[0]=__builtin_amdgcn_mfma_f32_32x32x16_bf16(PAF(0),VFR(0),o[0],0,0,0), C0,0); \
    GAPB(o[1]=__builtin_amdgcn_mfma_f32_32x32x16_bf16(PAF(0),VFR(4),o[1],0,0,0), C0,4); \
    KRD(GL,0); GAPB(o[0]=__builtin_amdgcn_mfma_f32_32x32x16_bf16(PAF(1),VFR(1),o[0],0,0,0), C0,8); \
    KRD(GL,1); GAPB(o[1]=__builtin_amdgcn_mfma_f32_32x32x16_bf16(PAF(1),VFR(5),o[1],0,0,0), C0,12); \
    KRD(GL,2); GAPB(o[0]=__builtin_amdgcn_mfma_f32_32x32x16_bf16(PAF(2),VFR(2),o[0],0,0,0), C1,0); \
    KRD(GL,3); GAPB(o[1]=__builtin_amdgcn_mfma_f32_32x32x16_bf16(PAF(2),VFR(6),o[1],0,0,0), C1,4); \
    GAPB(o[0]=__builtin_amdgcn_mfma_f32_32x32x16_bf16(PAF(3),VFR(3),o[0],0,0,0), C1,8); \
    GAPB(o[1]=__builtin_amdgcn_mfma_f32_32x32x16_bf16(PAF(3),VFR(7),o[1],0,0,0), C1,12); \
    }while(0)
  int t=1;
  #undef CMASK
  #define CMASK(P0,P1,t) do{ if(MOBA)selmask(P0,P1,sel,(t)>>2); }while(0)
  for(;t+5<NT;t+=2){
    STEP(pB0,pB1,pA0,pA1,t,true,true,true);     WAIT_BAR(2); RESC(); ROT();
    STEP(pA0,pA1,pB0,pB1,t+1,true,true,true);   WAIT_BAR(2); RESC(); ROT();
  }
  #undef CMASK
  #define CMASK(P0,P1,t) do{ if(MODE==1||MODE==3){int jb_=(t)-(NT-4); if(jb_>=0)cmask(P0,P1,jb_,qrel,hi); else if(MODE==1)selmask(P0,P1,sel,(t)>>2);} }while(0)
  #define ENDW(tt) do{ if((tt)+3<NT){WAIT_BAR(2);} else if((tt)+2<NT){WAIT_BAR(1);} else {WAIT_BAR(0);} }while(0)
  for(;t+1<NT;t+=2){
    STEP(pB0,pB1,pA0,pA1,t,(t+3<NT),(t+1<NT),(t+1<NT));       ENDW(t);   RESC(); ROT();
    STEP(pA0,pA1,pB0,pB1,t+1,(t+4<NT),(t+2<NT),(t+2<NT));     ENDW(t+1); RESC(); ROT();
  }
  if(x.nK){
    const bf16*ksn=x.nK+(long)lane*KP+wid*8; const bf16*vsn=x.nV+(long)(16*(wid&3)+(lane>>2))*KP+(wid>>2)*32+(lane&3)*8;
    glds16(ksn,(unsigned)__builtin_amdgcn_readfirstlane(kdst)); glds16(vsn,(unsigned)__builtin_amdgcn_readfirstlane(vdst)); glds16(ksn+(long)KVBLK*KP,(unsigned)__builtin_amdgcn_readfirstlane(kdst+SLOTB)); }
  STEP(pB0,pB1,pA0,pA1,NT-1,false,false,false); RESC();
  { float sacc=pB0[0]+pB0[1]; _Pragma("unroll") for(int r=2;r<16;++r)sacc+=pB0[r]; _Pragma("unroll") for(int r=0;r<16;++r)sacc+=pB1[r]; l_reg+=sacc;
    pw0=(u32x4){PKW(pB0,0),PKW(pB0,2),PKW(pB0,4),PKW(pB0,6)};pw1=(u32x4){PKW(pB0,8),PKW(pB0,10),PKW(pB0,12),PKW(pB0,14)};pw2=(u32x4){PKW(pB1,0),PKW(pB1,2),PKW(pB1,4),PKW(pB1,6)};pw3=(u32x4){PKW(pB1,8),PKW(pB1,10),PKW(pB1,12),PKW(pB1,14)};
    SBAR(); pv(o,vb0+sl_cur,PAF(0),PAF(1),PAF(2),PAF(3)); }
  #undef PKW
  #undef PAF
  #undef VFR
  #undef PIN
  #undef MX3
  #undef GAPA
  #undef GAPB
  #undef EX
  #undef VRD
  #undef KRD
  #undef STEP
  #undef ENDW
  {auto rr=__builtin_amdgcn_permlane32_swap(__float_as_uint(l_reg),__float_as_uint(l_reg),false,false);l_reg=__uint_as_float(rr[0])+__uint_as_float(rr[1]);}
  float*cw=(float*)(shm+LDS_CW)+wid*128;
  const int nsel=x.own<3?x.own:3;
  u32x4 pp[4][3];
  if(MODE==3){
    #pragma unroll
    for(int i=0;i<4;++i){ const bf16*po=x.part_o+((x.bhrow+(long)(x.own*QB+wid*QBLK+i*8+(lane>>3)))*3)*64+(lane&7)*8;
      #pragma unroll
      for(int s_=0;s_<3;++s_){ pp[i][s_]=u32x4{0u,0u,0u,0u}; if(s_<nsel) pp[i][s_]=*(const u32x4*)(po+s_*64); } } }
  if(hi==0){ wsf[32+r32]=l_reg;
    if(MODE==2){ const int li=wid*QBLK+r32; if(li<x.nvalid){ const unsigned e=eml; float*ml=x.part_ml+((x.bhrow+(long)(e&0x1fffu))*3+(e>>13))*2; ml[0]=mhat; ml[1]=l_reg; } }
    if(MODE==3){ float ms[3],ls[3]; float Mx=mhat;
      #pragma unroll
      for(int s_=0;s_<3;++s_){ ms[s_]=ms3[s_]; ls[s_]=ls3[s_]; if(s_<nsel) Mx=__builtin_fmaxf(Mx,ms[s_]); }
      float wo=__builtin_amdgcn_exp2f(mhat-Mx)*l_reg, L=wo, w_[3];
      #pragma unroll
      for(int s_=0;s_<3;++s_){ w_[s_]=(s_<nsel)?ls[s_]*__builtin_amdgcn_exp2f(ms[s_]-Mx):0.f; L+=w_[s_]; }
      const float inv=1.0f/L; cw[r32*4]=wo*inv; cw[r32*4+1]=w_[0]*inv; cw[r32*4+2]=w_[1]*inv; cw[r32*4+3]=w_[2]*inv; } }
  asm volatile("s_waitcnt lgkmcnt(0)":::"memory");
  float rli[16];
  #pragma unroll
  for(int r=0;r<16;++r)rli[r]=__builtin_amdgcn_rcpf(wsf[32+crow(r,hi)]);
  bf16*Ow=Ow0+(long)(wid*QBLK)*OP;
  { bf16*stg=(bf16*)(shm+LDS_OST)+wid*2048;
    #pragma unroll
    for(int r=0;r<16;++r){const int orow=crow(r,hi);
      #pragma unroll
      for(int d0=0;d0<2;++d0)stg[orow*64+d0*32+r32]=__float2bfloat16(o[d0][r]*rli[r]);}
    asm volatile("s_waitcnt lgkmcnt(0)":::"memory");
    #pragma unroll
    for(int i=0;i<4;++i){const int row=i*8+(lane>>3),ch=lane&7; const u32x4 v=*(const u32x4*)(stg+row*64+ch*8);
      if(MODE==2){ const int li=wid*QBLK+row; if(li<x.nvalid){ const unsigned e=el[i]; ATTN_STORE16(x.part_o+((x.bhrow+(long)(e&0x1fffu))*3+(e>>13))*64+ch*8,v); } }
      else if(MODE==3){ const float c0=cw[row*4]; float f[8];
        f[0]=c0*__uint_as_float(v.x<<16); f[1]=c0*__uint_as_float(v.x&0xffff0000u); f[2]=c0*__uint_as_float(v.y<<16); f[3]=c0*__uint_as_float(v.y&0xffff0000u);
        f[4]=c0*__uint_as_float(v.z<<16); f[5]=c0*__uint_as_float(v.z&0xffff0000u); f[6]=c0*__uint_as_float(v.w<<16); f[7]=c0*__uint_as_float(v.w&0xffff0000u);
        #pragma unroll
        for(int s_=0;s_<3;++s_){ if(s_<nsel){ const float cs_=cw[row*4+1+s_]; const u32x4 p=pp[i][s_];
          f[0]+=cs_*__uint_as_float(p.x<<16); f[1]+=cs_*__uint_as_float(p.x&0xffff0000u); f[2]+=cs_*__uint_as_float(p.y<<16); f[3]+=cs_*__uint_as_float(p.y&0xffff0000u);
          f[4]+=cs_*__uint_as_float(p.z<<16); f[5]+=cs_*__uint_as_float(p.z&0xffff0000u); f[6]+=cs_*__uint_as_float(p.w<<16); f[7]+=cs_*__uint_as_float(p.w&0xffff0000u); } }
        u32x4 w; w.x=cvtpk_s(f[0],f[1]); w.y=cvtpk_s(f[2],f[3]); w.z=cvtpk_s(f[4],f[5]); w.w=cvtpk_s(f[6],f[7]); ATTN_STORE16(Ow+(long)row*OP+ch*8,w); }
      else ATTN_STORE16(Ow+(long)row*OP+ch*8,v);} }
  asm volatile("s_waitcnt lgkmcnt(0)\n\ts_barrier":::"memory");
  #undef DMA_K
  #undef DMA_V
  #undef CMASK
  #undef START
  #undef RESC
  #undef ROT
}
constexpr int ATTN_LDS_BYTES=LDS_BYTES;
#undef SBAR
#undef WAIT_BAR
}
#define GAS __attribute__((address_space(1)))
#define LAS __attribute__((address_space(3)))
typedef unsigned short bf16;
typedef unsigned v4u __attribute__((ext_vector_type(4)));
typedef float f32x4 __attribute__((ext_vector_type(4)));
typedef short bf16x8 __attribute__((ext_vector_type(8)));
typedef GAS unsigned gu32;
typedef GAS unsigned long long gu64;
#define RLX_AGENT __ATOMIC_RELAXED, __HIP_MEMORY_SCOPE_AGENT
#define LDS_WAIT() asm volatile("s_waitcnt lgkmcnt(0)" ::: "memory")
#define VM_WAIT() asm volatile("s_waitcnt vmcnt(0)" ::: "memory")
__device__ __forceinline__ unsigned long long rt() { return __builtin_amdgcn_s_memrealtime(); }
__device__ __forceinline__ unsigned f2bf(float f) { unsigned u = __builtin_bit_cast(unsigned, f); return (u + 0x7fffu + ((u >> 16) & 1u)) >> 16; }
__device__ __forceinline__ unsigned pk2(float lo, float hi) { return f2bf(lo) | (f2bf(hi) << 16); }
#define XB_TMO      128
#define XB_XCNT(j)  (256  + 64 * (j))
#define XB_XSUB(j)  (1280 + 64 * (j))
#define XB_XGEN(j)  (2304 + 64 * (j))
#define XB_TOP      3328
#define XB_TOPGEN   3392
#define XCD_BAR_WORDS 3456
#define XB_SPIN_CAP (1u << 22)

__device__ __forceinline__ unsigned xb_ld(unsigned* p)              { return __hip_atomic_load(p, __ATOMIC_RELAXED, __HIP_MEMORY_SCOPE_AGENT); }
__device__ __forceinline__ unsigned xb_add(unsigned* p, unsigned v) { return __hip_atomic_fetch_add(p, v, __ATOMIC_RELAXED, __HIP_MEMORY_SCOPE_AGENT); }
__device__ __forceinline__ unsigned xb_xcc_id() { return (unsigned)__builtin_amdgcn_s_getreg((3 << 11) | 20) & 0xFu; }
#define XB_SPIN(cond, bar) do { unsigned _sp = 0; while (cond) { __builtin_amdgcn_s_sleep(1); \
    if ((++_sp & 255u) == 0u) { if (xb_ld(&(bar)[XB_TMO])) break; if (_sp > XB_SPIN_CAP) { atomicAdd(&(bar)[XB_TMO], 1u); break; } } } } while (0)

struct XcdBarrier {
    unsigned* bar; unsigned x;
    volatile LAS unsigned* st;
};

__device__ __forceinline__ XcdBarrier xcd_barrier_post(unsigned* bar, volatile LAS unsigned* st) {
    XcdBarrier b; b.bar = bar; b.x = xb_xcc_id(); b.st = st;
    if (threadIdx.x == 0) (void)xb_add(&bar[XB_XCNT(b.x)], 1u);
    return b;
}
__device__ __forceinline__ void xcd_barrier_complete(unsigned* bar, unsigned x, unsigned& nloc, unsigned& nx) {
    const unsigned G = gridDim.x * gridDim.y * gridDim.z;
    unsigned sum, cnt, mine, sp = 0u;
    for (;;) {
        sum = 0u; cnt = 0u; mine = 0u;
#pragma unroll
        for (unsigned j = 0; j < 16; ++j) { const unsigned c = xb_ld(&bar[XB_XCNT(j)]); sum += c; cnt += (c > 0u) ? 1u : 0u; mine = (j == x) ? c : mine; }
        if (sum == G) break;
        __builtin_amdgcn_s_sleep(1);
        if ((++sp & 255u) == 0u) { if (xb_ld(&bar[XB_TMO])) break; if (sp > XB_SPIN_CAP) { atomicAdd(&bar[XB_TMO], 1u); break; } }
    }
    nloc = mine > 0u ? mine : 1u; nx = cnt > 0u ? cnt : 1u;
}

__device__ __forceinline__ void xcd_barrier(const XcdBarrier& b) {
    asm volatile("s_waitcnt vmcnt(0)" ::: "memory");
    __syncthreads();
    if (threadIdx.x == 0) {
        unsigned* bar = b.bar;
        __builtin_amdgcn_s_waitcnt(0);
        unsigned nloc = b.st[0], nx = b.st[1];
        if (nloc == 0u) { xcd_barrier_complete(bar, b.x, nloc, nx); b.st[0] = nloc; b.st[1] = nx; }
        const unsigned old = xb_add(&bar[XB_XSUB(b.x)], 1u);
        const unsigned gen = old / nloc;
        if (old + 1u == (gen + 1u) * nloc) {
            __builtin_amdgcn_fence(__ATOMIC_RELEASE, "agent");
            asm volatile("s_waitcnt vmcnt(0)" ::: "memory");
            const unsigned og = xb_add(&bar[XB_TOP], 1u);
            const unsigned tg = og / nx;
            if (og + 1u == (tg + 1u) * nx) xb_add(&bar[XB_TOPGEN], 1u);
            else XB_SPIN(xb_ld(&bar[XB_TOPGEN]) == tg, bar);
            __builtin_amdgcn_fence(__ATOMIC_ACQUIRE, "agent");
            xb_add(&bar[XB_XGEN(b.x)], 1u);
            asm volatile("s_waitcnt vmcnt(0)" ::: "memory");
        } else {
            XB_SPIN(xb_ld(&bar[XB_XGEN(b.x)]) == gen, bar);
            __builtin_amdgcn_fence(__ATOMIC_ACQUIRE, "agent");
            asm volatile("s_waitcnt vmcnt(0)" ::: "memory");
        }
    }
    __syncthreads();
}

#define XB_LOC(j) (1024 + 64 * (j))
__device__ __forceinline__ void xcd_local_barrier(const XcdBarrier& b, unsigned* ctl, unsigned k) {
    asm volatile("s_waitcnt vmcnt(0)" ::: "memory");
    __syncthreads();
    if (threadIdx.x == 0) {
        const unsigned nloc = b.st[0]; unsigned* w = ctl + XB_LOC(b.x);
        __hip_atomic_fetch_add(w, 1u, __ATOMIC_RELAXED, __HIP_MEMORY_SCOPE_AGENT);
        const unsigned target = (k + 1u) * nloc;
        XB_SPIN(xb_ld(w) < target, b.bar);
        __builtin_amdgcn_fence(__ATOMIC_ACQUIRE, "agent");
        asm volatile("s_waitcnt vmcnt(0)" ::: "memory");
    }
    __syncthreads();
}
constexpr int NWAVES = 8;
constexpr int BATCH = 4, SEQ = 8192, D = 1024, M = BATCH * SEQ, DEPTH = 4;
constexpr int MIXW = 768, MEMW = 256, HD = 64, NH = 12, NMH = 4, MEMLEN = 256, FF = 2816, NE = 8;
constexpr int NINA = 3 * MIXW + MEMW;
constexpr int NBLK = SEQ / 256;
constexpr int NKV = 2 * MIXW;
constexpr int NMKV = 2 * MEMW;
constexpr int XS_ROWS = 67584;
constexpr float LN_EPS = 1e-5f;
constexpr float ALPHA = 1.681792830507429f;
constexpr float QK_C2 = 0.125f * 1.4426950408889634f;

constexpr size_t MiB = 1u << 20;
constexpr size_t WS_CTL = 0, CTL_ZERO_BYTES = 1 * MiB;
constexpr size_t WS_COS = 1 * MiB, WS_SIN = 2 * MiB;
constexpr size_t WS_KMEAN = 3 * MiB;
constexpr size_t WS_TOPI = 4 * MiB, WS_TOPG = WS_TOPI + 256 * 1024, WS_POS = WS_TOPG + 256 * 1024;
constexpr size_t WS_MEMB = 5 * MiB;
constexpr size_t WS_MEMKV = 7 * MiB;
constexpr size_t WS_WINA = 12 * MiB;
constexpr size_t WS_WQB = 22 * MiB;
constexpr size_t WS_WKV = 26 * MiB;
constexpr size_t WS_WMKV = 29 * MiB;
constexpr size_t WS_WO = 33 * MiB;
constexpr size_t WS_WGUD = 41 * MiB;
constexpr size_t WS_WDD = 63 * MiB;
constexpr size_t WS_WGUM = 74 * MiB;
constexpr size_t WS_WDM = 250 * MiB;
constexpr size_t WS_XB = 338 * MiB;
constexpr size_t WS_KS = 402 * MiB, WS_VS = 450 * MiB;
constexpr size_t WS_XS = 498 * MiB;
constexpr size_t WS_BIG = 630 * MiB;
constexpr size_t WS_PROJ = 1153 * MiB, WS_MIX = 1313 * MiB;
constexpr size_t WS_END = 993 * MiB;
static_assert(WS_XS + (size_t)XS_ROWS * D * 2 <= WS_BIG && WS_BIG + (size_t)XS_ROWS * FF * 2 <= WS_END && WS_PROJ + (size_t)M * 2560 * 2 <= WS_MIX && WS_MIX + (size_t)M * D * 2 <= 1377 * MiB, "ws map");
static_assert(WS_WDM + (size_t)16 * D * FF * 2 <= WS_XB && WS_WGUM + (size_t)16 * 2 * FF * D * 2 <= WS_WDM && WS_WDD + (size_t)2 * D * FF * 2 <= WS_WGUM && WS_WGUD + (size_t)2 * 2 * FF * D * 2 <= WS_WDD, "ws map weights");
constexpr int CW_BAR = 4096;
constexpr int CW_CNT = 8192, CW_CUR = 8192 + 1024;
constexpr int CW_XRANK = 3100;
constexpr int CW_CSU = 100000;
constexpr size_t WS_XQ = WS_XS + 96 * MiB;
constexpr size_t WS_RS = WS_POS + 256 * 1024;
constexpr int YP_ROWS = 2048;
constexpr size_t WS_YP = 1137 * MiB;
constexpr size_t WS_SRS = 11 * MiB;
constexpr size_t WS_CWV = 11 * MiB + 512 * 1024;
__host__ __device__ constexpr int cw_cnt(int ls, int e) { return CW_CNT + (ls * 8 + e) * 64; }
__host__ __device__ constexpr int cw_cur(int ls, int e) { return CW_CUR + (ls * 8 + e) * 64; }

constexpr int RING_OFF = 0, RING_BYTES = 131072;
constexpr int LDSCTL_OFF = RING_BYTES, MISC_OFF = LDSCTL_OFF + 320;
constexpr int LDS_BYTES = 147456;

struct Args { const float* in[18]; float* out; unsigned char* ws; double invf[8]; };
struct Frame {
    LAS unsigned char* lds; volatile LAS unsigned* MISC; unsigned* ctl;
    int wave, vcu, G, gw, NGW, cid, lok;
    unsigned char* ws; float* X; bf16* XB;
};
__device__ __forceinline__ int opaque_lane() { int t = threadIdx.x; asm volatile("" : "+v"(t)); return t & 63; }
template <int CTRL> __device__ __forceinline__ float dpp_f(float v) { return __builtin_bit_cast(float, __builtin_amdgcn_update_dpp(0, __builtin_bit_cast(int, v), CTRL, 0xf, 0xf, true)); }
template <int CTRL> __device__ __forceinline__ int dpp_i(int v) { return __builtin_amdgcn_update_dpp(0, v, CTRL, 0xf, 0xf, true); }
__device__ __forceinline__ float wave_sum(float v) {
    v += dpp_f<0xB1>(v); v += dpp_f<0x4E>(v); v += dpp_f<0x141>(v); v += dpp_f<0x140>(v);
    { auto r = __builtin_amdgcn_permlane16_swap(__float_as_uint(v), __float_as_uint(v), false, false); v = __uint_as_float(r[0]) + __uint_as_float(r[1]); }
    { auto r = __builtin_amdgcn_permlane32_swap(__float_as_uint(v), __float_as_uint(v), false, false); v = __uint_as_float(r[0]) + __uint_as_float(r[1]); }
    return v;
}
__device__ __forceinline__ float wave_max(float v) {
    v = __builtin_fmaxf(v, dpp_f<0xB1>(v)); v = __builtin_fmaxf(v, dpp_f<0x4E>(v)); v = __builtin_fmaxf(v, dpp_f<0x141>(v)); v = __builtin_fmaxf(v, dpp_f<0x140>(v));
    { auto r = __builtin_amdgcn_permlane16_swap(__float_as_uint(v), __float_as_uint(v), false, false); v = __builtin_fmaxf(__uint_as_float(r[0]), __uint_as_float(r[1])); }
    { auto r = __builtin_amdgcn_permlane32_swap(__float_as_uint(v), __float_as_uint(v), false, false); v = __builtin_fmaxf(__uint_as_float(r[0]), __uint_as_float(r[1])); }
    return v;
}
__device__ __forceinline__ int wave_sum_i(int v) {
    v += dpp_i<0xB1>(v); v += dpp_i<0x4E>(v); v += dpp_i<0x141>(v); v += dpp_i<0x140>(v);
    { auto r = __builtin_amdgcn_permlane16_swap((unsigned)v, (unsigned)v, false, false); v = (int)(r[0] + r[1]); }
    { auto r = __builtin_amdgcn_permlane32_swap((unsigned)v, (unsigned)v, false, false); v = (int)(r[0] + r[1]); }
    return v;
}
__device__ __forceinline__ float bflo(unsigned w) { return __uint_as_float(w << 16); }
__device__ __forceinline__ float bfhi(unsigned w) { return __uint_as_float(w & 0xffff0000u); }
__device__ __forceinline__ void unpack8(const v4u w, float (&f)[8]) { f[0] = bflo(w.x); f[1] = bfhi(w.x); f[2] = bflo(w.y); f[3] = bfhi(w.y); f[4] = bflo(w.z); f[5] = bfhi(w.z); f[6] = bflo(w.w); f[7] = bfhi(w.w); }
__device__ __forceinline__ v4u pack8(const float (&f)[8]) { v4u w; w.x = pk2(f[0], f[1]); w.y = pk2(f[2], f[3]); w.z = pk2(f[4], f[5]); w.w = pk2(f[6], f[7]); return w; }

template <int MODE>
__device__ __forceinline__ void p0_transpose_item(const float* W, int K, int N, bf16* WT, LAS float* scr, int item, int lane) {
    const int nblk = N / 32, kb = item / nblk, nb = item % nblk, k0 = 64 * kb, n0 = 32 * nb;
    int d0 = n0;
    if (MODE == 1) { const int f = n0 < FF ? n0 : n0 - FF; d0 = (f >> 7) * 256 + (f & 127) + (n0 < FF ? 0 : 128); }
#pragma unroll 8
    for (int i = 0; i < 32; ++i) { const int kk = 2 * i + (lane >> 5); scr[kk * 33 + (lane & 31)] = W[(size_t)(k0 + kk) * N + n0 + (lane & 31)]; }
    LDS_WAIT(); asm volatile("" ::: "memory");
    const int c = lane & 7;
#pragma unroll
    for (int j = 0; j < 4; ++j) { const int n = (lane >> 3) + 8 * j; const LAS float* s = scr + (8 * c) * 33 + n;
        v4u o; o.x = pk2(s[0 * 33], s[1 * 33]); o.y = pk2(s[2 * 33], s[3 * 33]); o.z = pk2(s[4 * 33], s[5 * 33]); o.w = pk2(s[6 * 33], s[7 * 33]);
        *(v4u*)(WT + (size_t)(d0 + n) * K + k0 + 8 * c) = o; }
    LDS_WAIT(); asm volatile("" ::: "memory");
}
__device__ __forceinline__ void sincos_f64(double a, float& s, float& c) {
    const double kd = __builtin_rint(a * 0.63661977236758134308);
    double r = __builtin_fma(-kd, 1.57079632673412561417e+00, a); r = __builtin_fma(-kd, 6.07710050650619224932e-11, r);
    const int q = ((int)kd) & 3; const double z = r * r;
    const double sp = r + r * z * (-1.66666666666666324348e-01 + z * (8.33333333332248946124e-03 + z * (-1.98412698298579493134e-04 + z * (2.75573137070700676789e-06 + z * (-2.50507602534068634195e-08 + z * 1.58969099521155010221e-10)))));
    const double cp = 1.0 - 0.5 * z + z * z * (4.16666666666666019037e-02 + z * (-1.38888888888741095749e-03 + z * (2.48015872894767294178e-05 + z * (-2.75573143513906633035e-07 + z * (2.08757232129817482790e-09 + z * -1.13596475577881948265e-11)))));
    const float sf = (float)sp, cf = (float)cp;
    s = (q == 0) ? sf : (q == 1) ? cf : (q == 2) ? -sf : -cf;
    c = (q == 0) ? cf : (q == 1) ? -sf : (q == 2) ? -cf : sf;
}
struct StripSrc { const float* W; int N, K, k0; unsigned char* dst; int drow; unsigned* csu; bool valid; };
constexpr int NQG = 18 * 176;
constexpr int NQS = NQG + 2 * 80;
constexpr int NBS = 2 * 32 + 48 + 4 * 16 + 4 * 32 + 2 * 32 * 3 + 16 * 32 * 3;
__device__ __forceinline__ StripSrc strip_src(Frame& F, const Args& args, int s) {
    StripSrc r; r.valid = s < NQS + NBS; r.csu = nullptr; r.W = args.in[3]; r.N = 32; r.K = 1024; r.k0 = 0; r.dst = F.ws; r.drow = 0;
    if (!r.valid) return r;
    if (s >= NQG && s < NQS) { const int q = s - NQG, mi = q / 80, n0 = (q % 80) * 32; r.drow = n0;
        r.W = args.in[3] + (size_t)mi * D * NINA + n0; r.N = NINA; r.K = D; r.k0 = 0; r.dst = F.ws + WS_WINA + (size_t)mi * NINA * D; r.csu = F.ctl + CW_CSU + 18 * 2 * FF + mi * NINA; return r; }
    if (s < NQG) { const int mi = s / 176, n0 = (s % 176) * 32; const int f = n0 < FF ? n0 : n0 - FF; r.drow = (f >> 7) * 256 + (f & 127) + (n0 < FF ? 0 : 128);
        r.W = (mi < 2 ? args.in[13] + (size_t)mi * D * 2 * FF : args.in[16] + (size_t)(mi - 2) * D * 2 * FF) + n0; r.N = 2 * FF; r.K = D; r.k0 = 0;
        r.dst = mi < 2 ? F.ws + WS_WGUD + (size_t)mi * 2 * FF * D : F.ws + WS_WGUM + (size_t)(mi - 2) * 2 * FF * D; r.csu = F.ctl + CW_CSU + mi * 2 * FF; return r; }
    int q = s - NQS;
#define SG(srcp, nmat, KK, NN, dstoff) { constexpr int KP_ = ((KK) + 1023) / 1024, SPM_ = ((NN) / 32) * KP_; if (q < (nmat) * SPM_) { const int mi = q / SPM_, u = q % SPM_, nb = u / KP_, kp = u % KP_; \
        r.W = (srcp) + (size_t)mi * (KK) * (NN) + (size_t)(kp * 1024) * (NN) + nb * 32; r.N = (NN); r.K = (KK); r.k0 = kp * 1024; r.dst = F.ws + (dstoff) + (size_t)mi * (NN) * (KK) * 2; r.drow = nb * 32; return r; } q -= (nmat) * SPM_; }
    SG(args.in[5], 2, D, D, WS_WQB) SG(args.in[6], 1, D, NKV, WS_WKV) SG(args.in[7], 4, D, NMKV, WS_WMKV) SG(args.in[8], 4, D, D, WS_WO)
    SG(args.in[14], 2, FF, D, WS_WDD) SG(args.in[17], 16, FF, D, WS_WDM)
#undef SG
    r.valid = false; return r;
}
__device__ __forceinline__ void strip_load(const StripSrc& S, int t, f32x4 (&v)[16]) {
    const int c4 = t & 7, kg = t >> 3;
    if (S.valid && S.k0 + kg * 16 < S.K) { const float* p = S.W + (size_t)(kg * 16) * S.N + 4 * c4;
#pragma unroll
        for (int j = 0; j < 16; ++j) v[j] = *(const f32x4*)(p + (size_t)j * S.N); }
    else {
#pragma unroll
        for (int j = 0; j < 16; ++j) v[j] = (f32x4){0.f, 0.f, 0.f, 0.f}; }
}
__device__ __forceinline__ void strip_store(Frame& F, const StripSrc& S, int t, const f32x4 (&v)[16]) {
    const int c4 = t & 7, kg = t >> 3; const bool act = S.valid && (S.k0 + kg * 16 < S.K);
    if (S.csu) {
        LAS float* red = (LAS float*)(F.lds + RING_OFF); LAS float* cmax = red + 64 * 32;
        float m4[4] = {0.f, 0.f, 0.f, 0.f};
#pragma unroll
        for (int j = 0; j < 16; ++j)
#pragma unroll
            for (int i = 0; i < 4; ++i) m4[i] = __builtin_fmaxf(m4[i], __builtin_fabsf(v[j][i]));
#pragma unroll
        for (int i = 0; i < 4; ++i) red[kg * 32 + 4 * c4 + i] = m4[i];
        __syncthreads();
        if (t < 32) { float am = 0.f;
#pragma unroll 8
            for (int g = 0; g < 64; ++g) am = __builtin_fmaxf(am, red[g * 32 + t]);
            cmax[t] = am; S.csu[S.drow + t] = __float_as_uint(am); }
        __syncthreads();
#pragma unroll
        for (int i = 0; i < 4; ++i) { const float am = cmax[4 * c4 + i]; const float inv = am > 0.f ? 127.0f / am : 0.f; v4u w;
#pragma unroll
            for (int dw = 0; dw < 4; ++dw) { unsigned x = 0u;
#pragma unroll
                for (int b = 0; b < 4; ++b) x |= ((unsigned)(int)__builtin_rintf(v[dw * 4 + b][i] * inv) & 0xffu) << (8 * b);
                w[dw] = x; }
            *(v4u*)(S.dst + (size_t)(S.drow + 4 * c4 + i) * S.K + S.k0 + kg * 16) = w; }
        __syncthreads();
    } else if (act) {
#pragma unroll
        for (int i = 0; i < 4; ++i) { v4u w0, w1;
            w0.x = pk2(v[0][i], v[1][i]); w0.y = pk2(v[2][i], v[3][i]); w0.z = pk2(v[4][i], v[5][i]); w0.w = pk2(v[6][i], v[7][i]);
            w1.x = pk2(v[8][i], v[9][i]); w1.y = pk2(v[10][i], v[11][i]); w1.z = pk2(v[12][i], v[13][i]); w1.w = pk2(v[14][i], v[15][i]);
            v4u* o = (v4u*)(S.dst + ((size_t)(S.drow + 4 * c4 + i) * S.K + S.k0 + kg * 16) * 2); o[0] = w0; o[1] = w1; }
    }
}
__device__ __forceinline__ void p0_prologue(Frame& F, const Args& args) {
    const int lane = opaque_lane();
    const float* const* in = args.in;
    bf16* ws16 = (bf16*)F.ws;
    {
        const int t = F.wave * 64 + lane; f32x4 va[16], vb[16];
        int s = F.vcu; StripSrc Sa = strip_src(F, args, s), Sb;
        strip_load(Sa, t, va);
        for (; s < NQS + NBS; s += 2 * F.G) {
            Sb = strip_src(F, args, s + F.G); strip_load(Sb, t, vb);
            strip_store(F, Sa, t, va);
            Sa = strip_src(F, args, s + 2 * F.G); strip_load(Sa, t, va);
            if (Sb.valid) strip_store(F, Sb, t, vb);
        }
        __syncthreads();
    }
    (void)ws16;
    const int gt = F.gw * 64 + lane, NT = F.NGW * 64;
    f32x4 na[4][4];
#pragma unroll
    for (int u = 0; u < 4; ++u) { const f32x4* xr = (const f32x4*)(in[0] + (size_t)(F.gw * 4 + u) * D); na[u][0] = xr[2 * lane]; na[u][1] = xr[2 * lane + 1]; na[u][2] = xr[128 + 2 * lane]; na[u][3] = xr[128 + 2 * lane + 1]; }
    for (int row0 = F.gw * 4; row0 < M; row0 += F.NGW * 4) {
        f32x4 a[4][4];
#pragma unroll
        for (int u = 0; u < 4; ++u)
#pragma unroll
            for (int q4 = 0; q4 < 4; ++q4) a[u][q4] = na[u][q4];
        { const int rn = row0 + F.NGW * 4 < M ? row0 + F.NGW * 4 : row0;
#pragma unroll
          for (int u = 0; u < 4; ++u) { const f32x4* xr = (const f32x4*)(in[0] + (size_t)(rn + u) * D); na[u][0] = xr[2 * lane]; na[u][1] = xr[2 * lane + 1]; na[u][2] = xr[128 + 2 * lane]; na[u][3] = xr[128 + 2 * lane + 1]; } }
#pragma unroll
        for (int u = 0; u < 4; ++u) { const int row = row0 + u; float am = 0.f;
#pragma unroll
            for (int q4 = 0; q4 < 4; ++q4)
#pragma unroll
                for (int i = 0; i < 4; ++i) am = __builtin_fmaxf(am, __builtin_fabsf(a[u][q4][i]));
            am = wave_max(am);
            const float inv = am > 0.f ? 127.0f / am : 0.f; unsigned q[4];
#pragma unroll
            for (int q4 = 0; q4 < 4; ++q4) { unsigned x = 0u;
#pragma unroll
                for (int i = 0; i < 4; ++i) x |= ((unsigned)(int)__builtin_rintf(a[u][q4][i] * inv) & 0xffu) << (8 * i);
                q[q4] = x; }
            v4u* xo = (v4u*)(F.XB + (size_t)row * D); v4u w0, w1;
            w0.x = pk2(a[u][0].x, a[u][0].y); w0.y = pk2(a[u][0].z, a[u][0].w); w0.z = pk2(a[u][1].x, a[u][1].y); w0.w = pk2(a[u][1].z, a[u][1].w);
            w1.x = pk2(a[u][2].x, a[u][2].y); w1.y = pk2(a[u][2].z, a[u][2].w); w1.z = pk2(a[u][3].x, a[u][3].y); w1.w = pk2(a[u][3].z, a[u][3].w);
            xo[lane] = w0; xo[64 + lane] = w1;
            unsigned char* xq = F.ws + WS_XQ + (size_t)row * D;
            *(uint2*)(xq + 8 * lane) = make_uint2(q[0], q[1]); *(uint2*)(xq + 512 + 8 * lane) = make_uint2(q[2], q[3]);
            if (lane == 0) ((float*)(F.ws + WS_RS))[row] = am * (1.0f / 127.0f); }
    }
    { const f32x4* x4 = (const f32x4*)in[1]; v4u* o = (v4u*)(F.ws + WS_MEMB);
      for (int i = gt; i < BATCH * MEMLEN * D / 8; i += NT) { const f32x4 a = x4[2 * i], b = x4[2 * i + 1]; v4u w; w.x = pk2(a.x, a.y); w.y = pk2(a.z, a.w); w.z = pk2(b.x, b.y); w.w = pk2(b.z, b.w); o[i] = w; } }
    { const int* pos = (const int*)in[2]; float* cs = (float*)(F.ws + WS_COS); float* sn = (float*)(F.ws + WS_SIN);
      for (int i = gt; i < M * 8; i += NT) { const double a = (double)pos[i >> 3] * args.invf[i & 7]; float s, c; sincos_f64(a, s, c); cs[i] = c; sn[i] = s; } }
}
template <bool ROUTER, bool COMBINE, bool FINAL, bool QUANT = false, bool OWN = false>
__device__ __forceinline__ void ln_phase(Frame& F, const float* gain, const float* bias, const float* wrt, int ls) {
    const int lane = opaque_lane();
    float gv[16], bv[16];
#pragma unroll
    for (int hf = 0; hf < 2; ++hf)
#pragma unroll
        for (int q4 = 0; q4 < 2; ++q4) { const f32x4 g4 = ((const f32x4*)gain)[hf * 128 + lane * 2 + q4], b4 = ((const f32x4*)bias)[hf * 128 + lane * 2 + q4];
#pragma unroll
            for (int i = 0; i < 4; ++i) { gv[hf * 8 + q4 * 4 + i] = g4[i]; bv[hf * 8 + q4 * 4 + i] = b4[i]; } }
    const int* POS = (const int*)(F.ws + WS_POS); const float* TOPG = (const float*)(F.ws + WS_TOPG); const bf16* Y = (const bf16*)(F.ws + WS_XS);
    int* TOPI = (int*)(F.ws + WS_TOPI); float* TOPGw = (float*)(F.ws + WS_TOPG);
    int c0 = 0, c1 = 0, c2 = 0, c3 = 0, c4 = 0, c5 = 0, c6 = 0, c7 = 0;
    f32x4 wr0[16], wr1[16];
    if (ROUTER) {
#pragma unroll
        for (int hf = 0; hf < 2; ++hf)
#pragma unroll
            for (int i = 0; i < 8; ++i) { const int k = hf * 512 + lane * 8 + i; wr0[hf * 8 + i] = ((const f32x4*)wrt)[2 * k]; wr1[hf * 8 + i] = ((const f32x4*)wrt)[2 * k + 1]; } }
    const int step = OWN ? 16 : F.NGW * 2; const int rfirst = OWN ? (F.cid & 7) * (M / 8) + (F.cid >> 3) * (M / 8 / 32) + F.wave * 2 : F.gw * 2; const int rend = OWN ? rfirst + (M / 8 / 32) - F.wave * 2 : M;
    static_assert(!OWN || (M / 8 / 32 == 128 && NWAVES == 8), "OWN row map");
    v4u nx[2][2], nx2[2][2], ny[2][2][2]; int np[2][2], fp[2][2]; float ng[2][2], fg[2][2];
    { const int rb = rfirst;
#pragma unroll
        for (int rr = 0; rr < 2; ++rr) { const v4u* xr = (const v4u*)(F.XB + (size_t)(rb + rr) * D); nx[rr][0] = xr[lane]; nx[rr][1] = xr[64 + lane]; }
        if (!ROUTER) { const int rb2 = rb + step < rend ? rb + step : rb;
#pragma unroll
            for (int rr = 0; rr < 2; ++rr) { const v4u* xr = (const v4u*)(F.XB + (size_t)(rb2 + rr) * D); nx2[rr][0] = xr[lane]; nx2[rr][1] = xr[64 + lane]; } }
        if (COMBINE) { const int rf = rb + step < rend ? rb + step : rb;
#pragma unroll
            for (int rr = 0; rr < 2; ++rr)
#pragma unroll
                for (int k = 0; k < 2; ++k) { np[rr][k] = POS[2 * (rb + rr) + k]; ng[rr][k] = TOPG[2 * (rb + rr) + k]; fp[rr][k] = POS[2 * (rf + rr) + k]; fg[rr][k] = TOPG[2 * (rf + rr) + k]; }
#pragma unroll
            for (int rr = 0; rr < 2; ++rr)
#pragma unroll
                for (int k = 0; k < 2; ++k) { const int pc = np[rr][k] < 2 * M ? np[rr][k] : 2 * M - 1; const v4u* y = (const v4u*)(Y + (size_t)pc * D); ny[rr][k][0] = y[lane]; ny[rr][k][1] = y[64 + lane]; } } }
    for (int rowb = rfirst; rowb < rend; rowb += step) {
        float v[2][16]; v4u cy[2][2][2]; int cp[2][2]; float cg[2][2];
#pragma unroll
        for (int rr = 0; rr < 2; ++rr) { float fa[8], fb[8]; unpack8(nx[rr][0], fa); unpack8(nx[rr][1], fb);
#pragma unroll
            for (int i = 0; i < 8; ++i) { v[rr][i] = fa[i]; v[rr][8 + i] = fb[i]; } }
        if (COMBINE) {
#pragma unroll
            for (int rr = 0; rr < 2; ++rr)
#pragma unroll
                for (int k = 0; k < 2; ++k) { cy[rr][k][0] = ny[rr][k][0]; cy[rr][k][1] = ny[rr][k][1]; cp[rr][k] = np[rr][k]; cg[rr][k] = ng[rr][k]; np[rr][k] = fp[rr][k]; ng[rr][k] = fg[rr][k]; } }
        { const int rn = rowb + step < rend ? rowb + step : rowb;
            const int rn2 = rowb + 2 * step < rend ? rowb + 2 * step : rowb;
#pragma unroll
            for (int rr = 0; rr < 2; ++rr) {
                if (ROUTER) { const v4u* xr = (const v4u*)(F.XB + (size_t)(rn + rr) * D); nx[rr][0] = xr[lane]; nx[rr][1] = xr[64 + lane]; }
                else { nx[rr][0] = nx2[rr][0]; nx[rr][1] = nx2[rr][1]; const v4u* xr = (const v4u*)(F.XB + (size_t)(rn2 + rr) * D); nx2[rr][0] = xr[lane]; nx2[rr][1] = xr[64 + lane]; } }
            if (COMBINE) { const int rf = rn + step < rend ? rn + step : rn;
#pragma unroll
                for (int rr = 0; rr < 2; ++rr)
#pragma unroll
                    for (int k = 0; k < 2; ++k) { const int pc = np[rr][k] < 2 * M ? np[rr][k] : 2 * M - 1; const v4u* y = (const v4u*)(Y + (size_t)pc * D); ny[rr][k][0] = y[lane]; ny[rr][k][1] = y[64 + lane];
                        fp[rr][k] = POS[2 * (rf + rr) + k]; fg[rr][k] = TOPG[2 * (rf + rr) + k]; } } }
        if (COMBINE) {
#pragma unroll
            for (int rr = 0; rr < 2; ++rr) { const int p0 = cp[rr][0], p1 = cp[rr][1]; const float g0 = cg[rr][0], g1 = cg[rr][1];
                float a0[8], a1[8], b0[8], b1[8];
                unpack8(cy[rr][0][0], a0); unpack8(cy[rr][0][1], a1); unpack8(cy[rr][1][0], b0); unpack8(cy[rr][1][1], b1);
                if (p0 >= 2 * M || p1 >= 2 * M) {
                    if (p0 >= 2 * M) { float t0[8], t1[8];
#pragma unroll
                        for (int i = 0; i < 8; ++i) { a0[i] = 0.f; a1[i] = 0.f; }
#pragma unroll
                        for (int sl = 0; sl < 4; ++sl) { const v4u* yp = (const v4u*)((const bf16*)(F.ws + WS_YP) + ((size_t)sl * YP_ROWS + (p0 - 2 * M)) * D); unpack8(yp[lane], t0); unpack8(yp[64 + lane], t1);
#pragma unroll
                            for (int i = 0; i < 8; ++i) { a0[i] += t0[i]; a1[i] += t1[i]; } } }
                    if (p1 >= 2 * M) { float t0[8], t1[8];
#pragma unroll
                        for (int i = 0; i < 8; ++i) { b0[i] = 0.f; b1[i] = 0.f; }
#pragma unroll
                        for (int sl = 0; sl < 4; ++sl) { const v4u* yp = (const v4u*)((const bf16*)(F.ws + WS_YP) + ((size_t)sl * YP_ROWS + (p1 - 2 * M)) * D); unpack8(yp[lane], t0); unpack8(yp[64 + lane], t1);
#pragma unroll
                            for (int i = 0; i < 8; ++i) { b0[i] += t0[i]; b1[i] += t1[i]; } } }
                }
#pragma unroll
                for (int i = 0; i < 8; ++i) { v[rr][i] = v[rr][i] * ALPHA + g0 * a0[i] + g1 * b0[i]; v[rr][8 + i] = v[rr][8 + i] * ALPHA + g0 * a1[i] + g1 * b1[i]; } }
        }
#pragma unroll
        for (int rr = 0; rr < 2; ++rr) { const int row = rowb + rr; float s = 0.f;
#pragma unroll
            for (int i = 0; i < 16; ++i) s += v[rr][i];
            const float mean = wave_sum(s) * (1.f / D); float s2 = 0.f;
#pragma unroll
            for (int i = 0; i < 16; ++i) { v[rr][i] -= mean; s2 += v[rr][i] * v[rr][i]; }
            const float rstd = 1.f / sqrtf(wave_sum(s2) * (1.f / D) + LN_EPS);
#pragma unroll
            for (int i = 0; i < 16; ++i) v[rr][i] = v[rr][i] * rstd * gv[i] + bv[i];
            if (FINAL) { f32x4* o = (f32x4*)(F.X + (size_t)row * D);
                o[lane * 2] = (f32x4){v[rr][0], v[rr][1], v[rr][2], v[rr][3]}; o[lane * 2 + 1] = (f32x4){v[rr][4], v[rr][5], v[rr][6], v[rr][7]};
                o[128 + lane * 2] = (f32x4){v[rr][8], v[rr][9], v[rr][10], v[rr][11]}; o[128 + lane * 2 + 1] = (f32x4){v[rr][12], v[rr][13], v[rr][14], v[rr][15]}; }
            else { v4u* xo = (v4u*)(F.XB + (size_t)row * D); v4u w0, w1;
                w0.x = pk2(v[rr][0], v[rr][1]); w0.y = pk2(v[rr][2], v[rr][3]); w0.z = pk2(v[rr][4], v[rr][5]); w0.w = pk2(v[rr][6], v[rr][7]);
                w1.x = pk2(v[rr][8], v[rr][9]); w1.y = pk2(v[rr][10], v[rr][11]); w1.z = pk2(v[rr][12], v[rr][13]); w1.w = pk2(v[rr][14], v[rr][15]);
                xo[lane] = w0; xo[64 + lane] = w1; }
            if (QUANT) {
                float am = 0.f;
#pragma unroll
                for (int i = 0; i < 16; ++i) am = __builtin_fmaxf(am, __builtin_fabsf(v[rr][i]));
                am = wave_max(am);
                const float inv = am > 0.f ? 127.0f / am : 0.f; unsigned q[4] = {0u, 0u, 0u, 0u};
#pragma unroll
                for (int i = 0; i < 16; ++i) q[i >> 2] |= ((unsigned)(int)__builtin_rintf(v[rr][i] * inv) & 0xffu) << (8 * (i & 3));
                unsigned char* xq = F.ws + WS_XQ + (size_t)row * D;
                *(uint2*)(xq + 8 * lane) = make_uint2(q[0], q[1]); *(uint2*)(xq + 512 + 8 * lane) = make_uint2(q[2], q[3]);
                if (lane == 0) ((float*)(F.ws + WS_RS))[row] = am * (1.0f / 127.0f);
            }
            if (ROUTER) {
                float lg[8];
#pragma unroll
                for (int e = 0; e < 8; ++e) lg[e] = 0.f;
#pragma unroll
                for (int hf = 0; hf < 2; ++hf)
#pragma unroll
                    for (int i = 0; i < 8; ++i) { const f32x4 w0 = wr0[hf * 8 + i], w1 = wr1[hf * 8 + i]; const float xv = v[rr][hf * 8 + i];
                        lg[0] += xv * w0.x; lg[1] += xv * w0.y; lg[2] += xv * w0.z; lg[3] += xv * w0.w; lg[4] += xv * w1.x; lg[5] += xv * w1.y; lg[6] += xv * w1.z; lg[7] += xv * w1.w; }
#pragma unroll
                for (int e = 0; e < 8; ++e) lg[e] = wave_sum(lg[e]);
                int i1 = 0; float l1 = lg[0];
#pragma unroll
                for (int e = 1; e < 8; ++e) if (lg[e] > l1) { l1 = lg[e]; i1 = e; }
                int i2 = -1; float l2 = -INFINITY;
#pragma unroll
                for (int e = 0; e < 8; ++e) if (e != i1 && lg[e] > l2) { l2 = lg[e]; i2 = e; }
                const float ex = __expf(l2 - l1); const float g1 = 1.f / (1.f + ex), g2 = ex * g1;
                if (lane == 0) { TOPI[2 * row] = i1; TOPI[2 * row + 1] = i2; TOPGw[2 * row] = g1; TOPGw[2 * row + 1] = g2; }
                c0 += (i1 == 0) + (i2 == 0); c1 += (i1 == 1) + (i2 == 1); c2 += (i1 == 2) + (i2 == 2); c3 += (i1 == 3) + (i2 == 3);
                c4 += (i1 == 4) + (i2 == 4); c5 += (i1 == 5) + (i2 == 5); c6 += (i1 == 6) + (i2 == 6); c7 += (i1 == 7) + (i2 == 7);
            }
        }
    }
    if (ROUTER) {
        int* CWV = (int*)(F.ws + WS_CWV); int* CB = (int*)(F.ws + WS_CWV) + 8 * 2048 * 2;
        LAS int* lc = (LAS int*)(F.lds + RING_OFF);
        if (F.wave == 0 && lane < 8) lc[lane] = 0;
        __syncthreads();
        if (lane == 0) { int* w = CWV + ((size_t)ls * 2048 + F.gw) * 8; w[0] = c0; w[1] = c1; w[2] = c2; w[3] = c3; w[4] = c4; w[5] = c5; w[6] = c6; w[7] = c7;
            __hip_atomic_fetch_add(lc + 0, c0, __ATOMIC_RELAXED, __HIP_MEMORY_SCOPE_WORKGROUP); __hip_atomic_fetch_add(lc + 1, c1, __ATOMIC_RELAXED, __HIP_MEMORY_SCOPE_WORKGROUP);
            __hip_atomic_fetch_add(lc + 2, c2, __ATOMIC_RELAXED, __HIP_MEMORY_SCOPE_WORKGROUP); __hip_atomic_fetch_add(lc + 3, c3, __ATOMIC_RELAXED, __HIP_MEMORY_SCOPE_WORKGROUP);
            __hip_atomic_fetch_add(lc + 4, c4, __ATOMIC_RELAXED, __HIP_MEMORY_SCOPE_WORKGROUP); __hip_atomic_fetch_add(lc + 5, c5, __ATOMIC_RELAXED, __HIP_MEMORY_SCOPE_WORKGROUP);
            __hip_atomic_fetch_add(lc + 6, c6, __ATOMIC_RELAXED, __HIP_MEMORY_SCOPE_WORKGROUP); __hip_atomic_fetch_add(lc + 7, c7, __ATOMIC_RELAXED, __HIP_MEMORY_SCOPE_WORKGROUP); }
        __syncthreads();
        if (F.wave == 0 && lane < 8) CB[((size_t)ls * 256 + F.vcu) * 8 + lane] = lc[lane];
    }
    if (ROUTER && lane == 0) {
        __hip_atomic_fetch_add(F.ctl + cw_cnt(ls, 0), (unsigned)c0, RLX_AGENT); __hip_atomic_fetch_add(F.ctl + cw_cnt(ls, 1), (unsigned)c1, RLX_AGENT);
        __hip_atomic_fetch_add(F.ctl + cw_cnt(ls, 2), (unsigned)c2, RLX_AGENT); __hip_atomic_fetch_add(F.ctl + cw_cnt(ls, 3), (unsigned)c3, RLX_AGENT);
        __hip_atomic_fetch_add(F.ctl + cw_cnt(ls, 4), (unsigned)c4, RLX_AGENT); __hip_atomic_fetch_add(F.ctl + cw_cnt(ls, 5), (unsigned)c5, RLX_AGENT);
        __hip_atomic_fetch_add(F.ctl + cw_cnt(ls, 6), (unsigned)c6, RLX_AGENT); __hip_atomic_fetch_add(F.ctl + cw_cnt(ls, 7), (unsigned)c7, RLX_AGENT);
    }
}
struct Segs { int ps[9]; };
__device__ __forceinline__ void load_segs(Frame& F, int ls, Segs& sg) {
    sg.ps[0] = 0;
#pragma unroll
    for (int e = 0; e < 8; ++e) { const unsigned c = __builtin_amdgcn_readfirstlane(__hip_atomic_load(F.ctl + cw_cnt(ls, e), RLX_AGENT)); sg.ps[e + 1] = sg.ps[e] + (int)((c + 255u) >> 8); }
}
__device__ __forceinline__ void scatter_phase(Frame& F, int ls) {
    const int lane = opaque_lane();
    v4u a[16];
    if (F.gw < M / 16) {
#pragma unroll
        for (int i = 0; i < 16; ++i) { const int r = (F.cid & 7) * (M / 8) + (F.cid >> 3) * 128 + F.wave * 2 + (i >> 1) * 16 + (i & 1); a[i] = ((const v4u*)(F.ws + WS_XQ + (size_t)r * D))[lane]; } }
    Segs sg; load_segs(F, ls, sg);
    const int* TOPI = (const int*)(F.ws + WS_TOPI); int* POS = (int*)(F.ws + WS_POS); unsigned char* XS = F.ws + WS_XS;
    const int* CWV = (const int*)(F.ws + WS_CWV) + (size_t)ls * 2048 * 8; const int* CB = (const int*)(F.ws + WS_CWV) + 8 * 2048 * 2 + (size_t)ls * 256 * 8;
    int pre[8];
#pragma unroll
    for (int e = 0; e < 8; ++e) pre[e] = 0;
    for (int v = lane; v < F.vcu; v += 64) { const int4 x0 = ((const int4*)(CB + (size_t)v * 8))[0], x1 = ((const int4*)(CB + (size_t)v * 8))[1];
        pre[0] += x0.x; pre[1] += x0.y; pre[2] += x0.z; pre[3] += x0.w; pre[4] += x1.x; pre[5] += x1.y; pre[6] += x1.z; pre[7] += x1.w; }
    if (lane < F.wave) { const int4 x0 = ((const int4*)(CWV + (size_t)(F.vcu * NWAVES + lane) * 8))[0], x1 = ((const int4*)(CWV + (size_t)(F.vcu * NWAVES + lane) * 8))[1];
        pre[0] += x0.x; pre[1] += x0.y; pre[2] += x0.z; pre[3] += x0.w; pre[4] += x1.x; pre[5] += x1.y; pre[6] += x1.z; pre[7] += x1.w; }
#pragma unroll
    for (int e = 0; e < 8; ++e) pre[e] = wave_sum_i(pre[e]) + sg.ps[e] * 256;
    if (F.gw < M / 16) {
        const int row = (F.cid & 7) * (M / 8) + (F.cid >> 3) * 128 + F.wave * 2 + (lane >> 1) * 16 + (lane & 1);
        int posk[2];
#pragma unroll
        for (int k = 0; k < 2; ++k) {
            const int e = (lane < 16) ? TOPI[2 * row + k] : -1; int pos = 0;
#pragma unroll
            for (int ee = 0; ee < 8; ++ee) {
                const unsigned long long mask = __ballot(e == ee);
                if (e == ee) pos = pre[ee] + (int)__popcll(mask & ((1ull << lane) - 1ull));
                pre[ee] += (int)__popcll(mask);
            }
            if (lane < 16) POS[2 * row + k] = pos;
            posk[k] = pos;
        }
        const float myrs = (lane < 16) ? ((const float*)(F.ws + WS_RS))[row] : 0.f;
        if (lane < 16) { ((float*)(F.ws + WS_SRS))[posk[0]] = myrs; ((float*)(F.ws + WS_SRS))[posk[1]] = myrs; }
#pragma unroll
        for (int i = 0; i < 16; ++i)
#pragma unroll
            for (int k = 0; k < 2; ++k) { const int p = __builtin_amdgcn_readlane(posk[k], i); ((v4u*)(XS + (size_t)p * D))[lane] = a[i]; }
    }
}
__device__ __forceinline__ void ropek_phase(Frame& F) {
    const int lane = opaque_lane();
    bf16* KS = (bf16*)(F.ws + WS_KS); const float* COS = (const float*)(F.ws + WS_COS); const float* SIN = (const float*)(F.ws + WS_SIN); float* KMEAN = (float*)(F.ws + WS_KMEAN);
    const int lr = lane >> 3, ch = lane & 7;
    for (int unit = F.gw; unit < BATCH * NH * NBLK; unit += F.NGW) {
        const int b = unit / (NH * NBLK), h = (unit / NBLK) % NH, n = unit % NBLK;
        float sum[8];
#pragma unroll
        for (int i = 0; i < 8; ++i) sum[i] = 0.f;
        for (int it0 = 0; it0 < 32; it0 += 8) {
            v4u wv[8];
#pragma unroll
            for (int j = 0; j < 8; ++j) wv[j] = *(const v4u*)(KS + (size_t)(b * SEQ + n * 256 + (it0 + j) * 8 + lr) * MIXW + h * HD + ch * 8);
#pragma unroll
            for (int j = 0; j < 8; ++j) {
                const int row = b * SEQ + n * 256 + (it0 + j) * 8 + lr; v4u* p = (v4u*)(KS + (size_t)row * MIXW + h * HD + ch * 8);
                float f[8], pf[8]; unpack8(wv[j], f);
#pragma unroll
                for (int i = 0; i < 8; ++i) pf[i] = __shfl_xor(f[i], 1);
                if (ch < 2) {
                    const f32x4 ca = ((const f32x4*)COS)[2 * row], cb = ((const f32x4*)COS)[2 * row + 1], sa = ((const f32x4*)SIN)[2 * row], sb = ((const f32x4*)SIN)[2 * row + 1];
                    const float cs[8] = {ca.x, ca.y, ca.z, ca.w, cb.x, cb.y, cb.z, cb.w}, sn[8] = {sa.x, sa.y, sa.z, sa.w, sb.x, sb.y, sb.z, sb.w};
#pragma unroll
                    for (int i = 0; i < 8; ++i) f[i] = (ch == 0) ? f[i] * cs[i] - pf[i] * sn[i] : f[i] * cs[i] + pf[i] * sn[i];
                    *p = pack8(f);
                }
#pragma unroll
                for (int i = 0; i < 8; ++i) sum[i] += f[i];
            }
        }
#pragma unroll
        for (int i = 0; i < 8; ++i) { float s = sum[i]; s += __shfl_xor(s, 8); s += __shfl_xor(s, 16); s += __shfl_xor(s, 32); sum[i] = s * (1.f / 256.f); }
        if (lane < 8) { float* o = KMEAN + (size_t)unit * HD + ch * 8;
#pragma unroll
            for (int i = 0; i < 8; ++i) o[i] = sum[i]; }
    }
}
__device__ __forceinline__ void conv_phase(Frame& F, const float* cw) {
    const int lane = opaque_lane();
    const bf16* PROJ = (const bf16*)(F.ws + WS_PROJ); bf16* MIX = (bf16*)(F.ws + WS_MIX);
    const int gt = F.gw * 64 + lane, NT = F.NGW * 64;
    for (int item = gt; item < (M / 32) * (MIXW / 8); item += NT) {
        const int chunk = item / (MIXW / 8), cg = item % (MIXW / 8), r0 = chunk * 32, c0 = cg * 8;
        float w0[8], w1[8], w2[8], p2[8], p1[8];
#pragma unroll
        for (int i = 0; i < 8; ++i) { w0[i] = cw[c0 + i]; w1[i] = cw[MIXW + c0 + i]; w2[i] = cw[2 * MIXW + c0 + i]; p2[i] = 0.f; p1[i] = 0.f; }
        if ((r0 & (SEQ - 1)) != 0) {
            float a[8], b[8];
            unpack8(*(const v4u*)(PROJ + (size_t)(r0 - 2) * NINA + MIXW + c0), a); unpack8(*(const v4u*)(PROJ + (size_t)(r0 - 2) * NINA + 2 * MIXW + c0), b);
#pragma unroll
            for (int i = 0; i < 8; ++i) p2[i] = a[i] * b[i];
            unpack8(*(const v4u*)(PROJ + (size_t)(r0 - 1) * NINA + MIXW + c0), a); unpack8(*(const v4u*)(PROJ + (size_t)(r0 - 1) * NINA + 2 * MIXW + c0), b);
#pragma unroll
            for (int i = 0; i < 8; ++i) p1[i] = a[i] * b[i];
        }
        v4u nb[4], nc[4], nh[4];
#pragma unroll
        for (int i4 = 0; i4 < 4; ++i4) { const size_t row = (size_t)(r0 + i4); nb[i4] = *(const v4u*)(PROJ + row * NINA + c0); nc[i4] = *(const v4u*)(PROJ + row * NINA + MIXW + c0); nh[i4] = *(const v4u*)(PROJ + row * NINA + 2 * MIXW + c0); }
        for (int rb = 0; rb < 32; rb += 4) {
            v4u lb[4], lc[4], lh[4];
#pragma unroll
            for (int i4 = 0; i4 < 4; ++i4) { lb[i4] = nb[i4]; lc[i4] = nc[i4]; lh[i4] = nh[i4]; }
            { const int rbn = rb + 4 < 32 ? rb + 4 : rb;
#pragma unroll
              for (int i4 = 0; i4 < 4; ++i4) { const size_t row = (size_t)(r0 + rbn + i4); nb[i4] = *(const v4u*)(PROJ + row * NINA + c0); nc[i4] = *(const v4u*)(PROJ + row * NINA + MIXW + c0); nh[i4] = *(const v4u*)(PROJ + row * NINA + 2 * MIXW + c0); } }
#pragma unroll
            for (int i4 = 0; i4 < 4; ++i4) { const size_t row = (size_t)(r0 + rb + i4); float ub[8], uc[8], uh[8], o[8];
                unpack8(lb[i4], ub); unpack8(lc[i4], uc); unpack8(lh[i4], uh);
#pragma unroll
                for (int i = 0; i < 8; ++i) { const float cu = uc[i] * uh[i]; o[i] = ub[i] * (w0[i] * p2[i] + w1[i] * p1[i] + w2[i] * cu); p2[i] = p1[i]; p1[i] = cu; }
                *(v4u*)(MIX + row * D + c0) = pack8(o); }
        }
    }
}
constexpr size_t WS_LIST = WS_XS;
constexpr size_t WS_PML = WS_XS + 32 * MiB;
constexpr size_t WS_PO = 993 * MiB;
constexpr size_t WS_END2 = 1377 * MiB;
constexpr int LIST_CAP = 7936;
constexpr int CW_QUEUE = 12288, CW_MCNT = 16384, MCNT_WORDS = 32768;
static_assert(WS_PML + (size_t)BATCH * NH * SEQ * 3 * 2 * 4 <= WS_BIG && WS_LIST + (size_t)BATCH * NH * NBLK * LIST_CAP * 2 <= WS_PML && WS_PO + (size_t)BATCH * NH * SEQ * 3 * 64 * 2 <= WS_END2, "ws map (attention)");
static_assert((CW_MCNT + 2 * MCNT_WORDS) * 4 <= (int)CTL_ZERO_BYTES, "ctl map");

__device__ __forceinline__ void select_phase(Frame& F, int lslot) {
    typedef attn_body::bf16 ab;
    const int lane = opaque_lane(), r32 = lane & 31, hi = lane >> 5, tid = F.wave * 64 + lane;
    const ab* Q = (const ab*)(F.ws + WS_PROJ); const float* KMEAN = (const float*)(F.ws + WS_KMEAN);
    unsigned short* LIST = (unsigned short*)(F.ws + WS_LIST); unsigned* CNT = F.ctl + CW_MCNT + lslot * MCNT_WORDS;
    constexpr int MAXU = 6;
    LAS unsigned* lc = (LAS unsigned*)(F.lds + RING_OFF);
    constexpr int NU = BATCH * NH * NBLK; const int per = (NU + F.G - 1) / F.G;
    for (int j0 = 0; j0 < per; j0 += MAXU) {
        for (int i = tid; i < MAXU * 64; i += NWAVES * 64) lc[i] = 0u;
        __syncthreads();
        unsigned pk[MAXU]; unsigned lp[MAXU][3];
#pragma unroll
        for (int j = 0; j < MAXU; ++j) {
            pk[j] = 0u; lp[j][0] = 0u; lp[j][1] = 0u; lp[j][2] = 0u;
            const int u = F.vcu * per + j0 + j; const int bh = u / NBLK, own = u % NBLK, b = bh / NH, h = bh % NH;
            if (j0 + j < per && u < NU && own > 0) {
                const int t = own * 256 + F.wave * 32 + r32;
                const ab* qp = Q + ((size_t)(b * SEQ + t)) * D + h * HD + hi * 8;
                attn_body::bf16x8 qr[4];
#pragma unroll
                for (int d0 = 0; d0 < 4; ++d0) qr[d0] = *reinterpret_cast<const attn_body::bf16x8*>(qp + d0 * 16);
                pk[j] = attn_body::moba_select<true>(qr, KMEAN + (size_t)bh * NBLK * HD, own, r32, hi, KMEAN + (size_t)BATCH * NH * NBLK * HD + (size_t)bh * NBLK * HD);
                const int nv = (int)(pk[j] >> 24);
                if (hi == 0) {
#pragma unroll
                    for (int k = 0; k < 3; ++k) if (k < nv) lp[j][k] = __hip_atomic_fetch_add(lc + j * 64 + ((pk[j] >> (8 * k)) & 0xffu), 1u, __ATOMIC_RELAXED, __HIP_MEMORY_SCOPE_WORKGROUP);
                }
            }
        }
        __syncthreads();
        if (tid < MAXU * 32) { const int j = tid >> 5, n = tid & 31; const int u = F.vcu * per + j0 + j; const int bh = u / NBLK, own = u % NBLK;
            if (j0 + j < per && u < NU && n < own) { const unsigned c = lc[j * 64 + n]; unsigned base = 0u; if (c) base = __hip_atomic_fetch_add(CNT + (bh * NBLK + n) * 16, c, RLX_AGENT); lc[j * 64 + 32 + n] = base; } }
        __syncthreads();
        if (hi == 0) {
#pragma unroll
            for (int j = 0; j < MAXU; ++j) { const int u = F.vcu * per + j0 + j; const int bh = u / NBLK, own = u % NBLK; const int t = own * 256 + F.wave * 32 + r32; const int nv = (int)(pk[j] >> 24);
#pragma unroll
                for (int k = 0; k < 3; ++k) if (k < nv) { const unsigned n = (pk[j] >> (8 * k)) & 0xffu;
                    LIST[(size_t)(bh * NBLK + n) * LIST_CAP + lc[j * 64 + 32 + n] + lp[j][k]] = (unsigned short)(t | (k << 13)); } }
        }
        __syncthreads();
    }
}
template <int LDQ>
__device__ __forceinline__ void gather_phase(Frame& F, char* lds, int lslot, const bf16* qmem, int layer) {
    typedef attn_body::bf16 ab;
    const ab* Q = (const ab*)(F.ws + WS_PROJ); const ab* KS = (const ab*)(F.ws + WS_KS); const ab* VS = (const ab*)(F.ws + WS_VS); ab* MIX = (ab*)(F.ws + WS_MIX);
    const unsigned short* LIST = (const unsigned short*)(F.ws + WS_LIST); unsigned* CNT = F.ctl + CW_MCNT + lslot * MCNT_WORDS;
    const ab* MKV = (const ab*)(F.ws + WS_MEMKV); const ab* qm16 = (const ab*)qmem;
    constexpr int NITEM = BATCH * NH * NBLK, NMEMU = BATCH * NMH * NBLK;
    LAS int* cl = (LAS int*)(F.lds + RING_OFF + 106496);
    static_assert(attn_body::ATTN_LDS_BYTES <= 106496 && 106496 + NITEM * 4 <= RING_BYTES, "lds map (gather)");
    for (int i = threadIdx.x; i < NITEM; i += NWAVES * 64) cl[i] = (int)CNT[i * 16];
    if (threadIdx.x == 0) F.MISC[0] = __hip_atomic_fetch_add(F.ctl + CW_QUEUE + lslot * 64, 1u, RLX_AGENT);
    __syncthreads();
    int item = (int)F.MISC[0];
    __syncthreads();
    for (;;) {
        if (item >= NITEM + NMEMU) break;
        unsigned nxt_item = 0u; if (threadIdx.x == 0) nxt_item = __hip_atomic_fetch_add(F.ctl + CW_QUEUE + lslot * 64, 1u, RLX_AGENT);
        if (item < NITEM) {
            const int n = item / (BATCH * NH), bh = item % (BATCH * NH), b = bh / NH, h = bh % NH;
            const int cnt = (int)__builtin_amdgcn_readfirstlane(cl[bh * NBLK + n]);
            const long krow = (long)b * SEQ + n * 256;
            const unsigned short* L = LIST + (size_t)(bh * NBLK + n) * LIST_CAP; const ab* Qb = Q + (long)b * SEQ * D + h * HD;
            const int lane = opaque_lane(), li = F.wave * 32 + (lane & 31), hi8 = (lane >> 5) * 8;
#define GQ_ENTRY(c0_) ((c0_) < cnt ? (unsigned)L[(c0_) + (li < ((cnt - (c0_)) < 256 ? (cnt - (c0_)) : 256) ? li : 0)] : 0u)
#define GQ_LOAD(e_, q_) do { const ab* p_ = Qb + (long)((e_) & 0x1fffu) * D + hi8; _Pragma("unroll") for (int d0 = 0; d0 < 4; ++d0) (q_)[d0] = *reinterpret_cast<const attn_body::bf16x8*>(p_ + d0 * 16); } while (0)
            attn_body::bf16x8 qc[4], qn[4];
            if (cnt > 0) { const unsigned e0 = GQ_ENTRY(0); GQ_LOAD(e0, qc); }
            unsigned e_nx = GQ_ENTRY(256);
            for (int c0 = 0; c0 < cnt; c0 += 256) {
                if (c0 + 256 < cnt) GQ_LOAD(e_nx, qn);
                const unsigned e_nx2 = GQ_ENTRY(c0 + 512);
                attn_body::AttnX x{L + c0, (cnt - c0) < 256 ? (cnt - c0) : 256, (ab*)(F.ws + WS_PO), (float*)(F.ws + WS_PML), (long)bh * SEQ, 0, c0 > 0 ? 1 : 0, 0, nullptr, nullptr};
                attn_body::attn_unit<8, 2, D, MIXW, D>(0, Qb, KS + krow * MIXW + h * HD, VS + krow * MIXW + h * HD, nullptr, nullptr, lds, x, qc);
#pragma unroll
                for (int d0 = 0; d0 < 4; ++d0) qc[d0] = qn[d0];
                e_nx = e_nx2;
            }
#undef GQ_ENTRY
#undef GQ_LOAD
        } else {
            const int u = item - NITEM, bh = u / NBLK, qb = u % NBLK, b = bh / NMH, hm = bh % NMH; const long qrow = (long)b * SEQ + qb * 256;
            const ab* Kp = MKV + (size_t)(b * MEMLEN) * (DEPTH * NMKV) + layer * NMKV + hm * HD;
            attn_body::AttnX x{nullptr, 0, nullptr, nullptr, 0, 0, 0, 0, nullptr, nullptr};
            attn_body::attn_unit<8, 0, LDQ, DEPTH * NMKV, D>(0, qm16 + qrow * LDQ + hm * HD, Kp, Kp + MEMW, MIX + qrow * D + MIXW + hm * HD, nullptr, lds, x);
        }
        if (threadIdx.x == 0) F.MISC[0] = nxt_item;
        __syncthreads();
        item = (int)F.MISC[0];
        __syncthreads();
    }
}
__device__ __forceinline__ void own_phase(Frame& F, char* lds) {
    typedef attn_body::bf16 ab;
    const ab* Q = (const ab*)(F.ws + WS_PROJ); const ab* KS = (const ab*)(F.ws + WS_KS); const ab* VS = (const ab*)(F.ws + WS_VS); ab* MIX = (ab*)(F.ws + WS_MIX);
    constexpr int NU = BATCH * NH * NBLK; const int per = (NU + F.G - 1) / F.G;
    for (int j = 0; j < per; ++j) {
        const int lu = (F.cid >> 3) * per + j; if (lu >= 16 * NH) break;
        const int panel = (F.cid & 7) * 16 + lu / NH, h = lu % NH, b = panel / NBLK, own = panel % NBLK, bh = b * NH + h; const long qrow = (long)b * SEQ + own * 256;
        const bool hasn = (j + 1 < per) && (lu + 1 < 16 * NH);
        const int lu1 = lu + 1, panel1 = (F.cid & 7) * 16 + lu1 / NH, h1 = lu1 % NH, own1 = panel1 % NBLK; const long krow1 = (long)(panel1 / NBLK) * SEQ + own1 * 256;
        attn_body::AttnX x{nullptr, 0, (ab*)(F.ws + WS_PO), (float*)(F.ws + WS_PML), (long)bh * SEQ, own, 0, j > 0 ? 1 : 0, hasn ? KS + krow1 * MIXW + h1 * HD : nullptr, hasn ? VS + krow1 * MIXW + h1 * HD : nullptr};
        attn_body::attn_unit<8, 3, D, MIXW, D>(0, Q + qrow * D + h * HD, KS + qrow * MIXW + h * HD, VS + qrow * MIXW + h * HD, MIX + qrow * D + h * HD, nullptr, lds, x);
    }
}
template <int LDQ>
__device__ __forceinline__ void memattn_phase(Frame& F, char* lds, const bf16* qbase, int layer) {
    typedef attn_body::bf16 ab;
    const ab* MKV = (const ab*)(F.ws + WS_MEMKV); ab* MIX = (ab*)(F.ws + WS_MIX); const ab* qb16 = (const ab*)qbase;
    constexpr int NU = BATCH * NMH * NBLK; const int per = (NU + F.G - 1) / F.G;
    for (int i = 0; i < per; ++i) {
        const int u = F.vcu * per + i; if (u >= NU) break;
        const int bh = u / NBLK, qb = u % NBLK, b = bh / NMH, hm = bh % NMH; const long qrow = (long)b * SEQ + qb * 256;
        const ab* Kp = MKV + (size_t)(b * MEMLEN) * (DEPTH * NMKV) + layer * NMKV + hm * HD;
        const bool same = (i > 0) && ((u - 1) / NBLK == bh);
        attn_body::AttnX x{nullptr, 0, nullptr, nullptr, 0, 0, same ? 1 : 0, 0, nullptr, nullptr};
        attn_body::attn_unit<8, 0, LDQ, DEPTH * NMKV, D>(0, qb16 + qrow * LDQ + hm * HD, Kp, Kp + MEMW, MIX + qrow * D + MIXW + hm * HD, nullptr, lds, x);
    }
}
#ifndef WGM_UP
#define WGM_UP 4
#endif
#ifndef WGM_DOWN
#define WGM_DOWN 4
#endif
#ifndef WGM_PROJ
#define WGM_PROJ 4
#endif
template <int layer>
__device__ __forceinline__ void layer_body(Frame& F, const Args& args, const XcdBarrier& bar) {
#define GRID_BAR() xcd_barrier(bar)
#define SEAM_BAR(on_, k_) do { if ((on_) && F.lok) xcd_local_barrier(bar, F.ctl, (unsigned)(k_)); else xcd_barrier(bar); } while (0)
    unsigned char* ws = args.ws;
    const pg8::bf16_t* XBc = (const pg8::bf16_t*)(ws + WS_XB);
    pg8::bf16_t* PROJ = (pg8::bf16_t*)(ws + WS_PROJ); pg8::bf16_t* MIXp = (pg8::bf16_t*)(ws + WS_MIX); pg8::bf16_t* HB = (pg8::bf16_t*)(ws + WS_BIG); pg8::bf16_t* XSp = (pg8::bf16_t*)(ws + WS_XS);
    const int cid = F.cid;
        constexpr bool isA = layer < 2, isMoe = (layer & 1) != 0; constexpr int ls = layer >> 1;
        constexpr bool S0 = !isA, S1 = true, S2 = !isMoe, S3 = !isMoe, S4 = !isMoe, S5 = !isMoe || layer == 1;
        constexpr int LB = layer == 0 ? 0 : layer == 1 ? 5 : layer == 2 ? 7 : 13;
        constexpr int K0 = LB, K1 = K0 + (S0 ? 1 : 0), K2 = K1 + (S1 ? 1 : 0), K3 = K2 + (S2 ? 1 : 0), K4 = K3 + (S3 ? 1 : 0), K5 = K4 + (S4 ? 1 : 0);
        if constexpr (isA) {
            pg8::Gemm g{(const pg8::bf16_t*)(ws + WS_XQ), (const pg8::bf16_t*)(ws + WS_WINA + (size_t)layer * NINA * D), M, NINA, D / 2, D / 2, 0}; pg8::PanelOrder S; S.init(M / 256, NINA / 256, F.G, cid);
            pg8::EpiQ8 E{PROJ, NINA, 9, QK_C2, (const float*)(ws + WS_RS), F.ctl + CW_CSU + 18 * 2 * FF + layer * NINA};
            S.wgm = WGM_PROJ;
            pg8::gemm_phase<pg8::EpiQ8, pg8::PanelOrder, true, true, true>(F.lds + RING_OFF, g, S, E);
        } else {
            pg8::Gemm g{XBc, (const pg8::bf16_t*)(ws + WS_WQB) + (size_t)(layer - 2) * D * D, M, D, D, D, 0}; pg8::PanelOrder S; S.init(M / 256, D / 256, F.G, cid);
            pg8::EpiQ<false> E{PROJ, D, 3, 3, (const float*)(ws + WS_COS), (const float*)(ws + WS_SIN), QK_C2, nullptr, nullptr};
            pg8::gemm_phase<pg8::EpiQ<false>, pg8::PanelOrder, true, true>(F.lds + RING_OFF, g, S, E);
        }
        if constexpr (layer == 0) {
            pg8::Gemm g{(const pg8::bf16_t*)(ws + WS_MEMB), (const pg8::bf16_t*)(ws + WS_WMKV), BATCH * MEMLEN, DEPTH * NMKV, D, D, 0}; pg8::PanelOrder S; S.init(BATCH * MEMLEN / 256, DEPTH * NMKV / 256, F.G, cid);
            pg8::EpiBf16 E{(pg8::bf16_t*)(ws + WS_MEMKV), DEPTH * NMKV, 0, 0, 0, 0};
            pg8::gemm_phase<pg8::EpiBf16, pg8::PanelOrder, true, true>(F.lds + RING_OFF, g, S, E);
        }
        GRID_BAR();
        if constexpr (isA) { conv_phase(F, args.in[4] + (size_t)layer * 3 * MIXW); memattn_phase<NINA>(F, (char*)F.lds + RING_OFF, (const bf16*)(ws + WS_PROJ) + 3 * MIXW, layer); }
        else     { select_phase(F, layer - 2); GRID_BAR();
                   gather_phase<D>(F, (char*)F.lds + RING_OFF, layer - 2, (const bf16*)(ws + WS_PROJ) + MIXW, layer); GRID_BAR();
                   own_phase(F, (char*)F.lds + RING_OFF); }
        SEAM_BAR(S0, K0);
        {
            pg8::Gemm g{MIXp, (const pg8::bf16_t*)(ws + WS_WO) + (size_t)layer * D * D, M, D, D, D, 0}; pg8::PanelOrder S; S.init(M / 256, D / 256, F.G, cid);
            pg8::EpiRes E{(pg8::bf16_t*)(ws + WS_XB), D, ALPHA};
            pg8::gemm_phase<pg8::EpiRes, pg8::PanelOrder, true, true>(F.lds + RING_OFF, g, S, E);
        }
        SEAM_BAR(S1, K1);
        if constexpr (isMoe) ln_phase<true, false, false, true, true>(F, args.in[9] + layer * D, args.in[10] + layer * D, args.in[15] + (size_t)ls * D * NE, ls);
        else       ln_phase<false, false, false, true, true>(F, args.in[9] + layer * D, args.in[10] + layer * D, nullptr, 0);
        SEAM_BAR(S2, K2);
        if constexpr (isMoe) { scatter_phase(F, ls); GRID_BAR(); }
        {
            pg8::PanelOrder S; pg8::EpiGluQ E{HB, FF, nullptr, nullptr, 0x7fffffff, 0x7fffffff, 0x7fffffff, 0x7fffffff, 0x7fffffff, 0x7fffffff, 0x7fffffff, 0};
            const unsigned char* A8; const unsigned char* B8;
            if constexpr (isMoe) { Segs sg; load_segs(F, ls, sg); S.init(sg.ps[8], 2 * FF / 256, F.G, cid);
                S.ps1 = sg.ps[1]; S.ps2 = sg.ps[2]; S.ps3 = sg.ps[3]; S.ps4 = sg.ps[4]; S.ps5 = sg.ps[5]; S.ps6 = sg.ps[6]; S.ps7 = sg.ps[7]; S.estride = (size_t)2 * FF * D;
                E.ps1 = sg.ps[1]; E.ps2 = sg.ps[2]; E.ps3 = sg.ps[3]; E.ps4 = sg.ps[4]; E.ps5 = sg.ps[5]; E.ps6 = sg.ps[6]; E.ps7 = sg.ps[7]; E.cs_estride = 2 * FF;
                E.rs = (const float*)(ws + WS_SRS); E.csu = F.ctl + CW_CSU + (2 + ls * NE) * 2 * FF;
                A8 = ws + WS_XS; B8 = ws + WS_WGUM + (size_t)ls * NE * 2 * FF * D; }
            else { S.init(M / 256, 2 * FF / 256, F.G, cid); E.rs = (const float*)(ws + WS_RS); E.csu = F.ctl + CW_CSU + ls * 2 * FF;
                A8 = ws + WS_XQ; B8 = ws + WS_WGUD + (size_t)ls * 2 * FF * D; }
            pg8::Gemm g{(const pg8::bf16_t*)A8, (const pg8::bf16_t*)B8, M, 2 * FF, D / 2, D / 2, 0};
            S.wgm = WGM_UP;
            pg8::gemm_phase<pg8::EpiGluQ, pg8::PanelOrder, true, true, true>(F.lds + RING_OFF, g, S, E);
        }
        SEAM_BAR(S3, K3);
        if constexpr (isMoe) {
            Segs sg; load_segs(F, ls, sg); const pg8::bf16_t* Wd = (const pg8::bf16_t*)(ws + WS_WDM) + (size_t)ls * NE * D * FF;
            { pg8::PanelOrder S; S.init(256, D / 256, F.G, cid);
              S.ps1 = sg.ps[1]; S.ps2 = sg.ps[2]; S.ps3 = sg.ps[3]; S.ps4 = sg.ps[4]; S.ps5 = sg.ps[5]; S.ps6 = sg.ps[6]; S.ps7 = sg.ps[7]; S.estride = (size_t)D * FF * 2;
              S.wgm = WGM_DOWN;
              pg8::Gemm g{HB, Wd, M, D, FF, FF, 0};
              pg8::EpiBf16 E{XSp, D, 0, 0, 0, 0};
              pg8::gemm_phase<pg8::EpiBf16, pg8::PanelOrder, true, true>(F.lds + RING_OFF, g, S, E); }
            { pg8::PanelOrder S; S.init(sg.ps[8] - 256, (D / 256) * 2, F.G, cid); S.pm0 = 256; S.nNr = D / 256;
              S.ps1 = sg.ps[1]; S.ps2 = sg.ps[2]; S.ps3 = sg.ps[3]; S.ps4 = sg.ps[4]; S.ps5 = sg.ps[5]; S.ps6 = sg.ps[6]; S.ps7 = sg.ps[7]; S.estride = (size_t)D * FF * 2;
              pg8::Gemm g{HB, Wd, M, D, 640, FF, (size_t)640 * 2};
              pg8::EpiBf16 E{(pg8::bf16_t*)(ws + WS_YP), D, 0, 0, 2 * M, (size_t)YP_ROWS * D};
              pg8::gemm_phase<pg8::EpiBf16, pg8::PanelOrder, true, true>(F.lds + RING_OFF, g, S, E); }
            { pg8::PanelOrder S; S.init(sg.ps[8] - 256, (D / 256) * 2, F.G, (cid + 128) % F.G); S.pm0 = 256; S.nNr = D / 256;
              S.ps1 = sg.ps[1]; S.ps2 = sg.ps[2]; S.ps3 = sg.ps[3]; S.ps4 = sg.ps[4]; S.ps5 = sg.ps[5]; S.ps6 = sg.ps[6]; S.ps7 = sg.ps[7]; S.estride = (size_t)D * FF * 2;
              pg8::Gemm g{HB + 1280, Wd + 1280, M, D, 768, FF, (size_t)768 * 2};
              pg8::EpiBf16 E{(pg8::bf16_t*)(ws + WS_YP) + (size_t)2 * YP_ROWS * D, D, 0, 0, 2 * M, (size_t)YP_ROWS * D};
              pg8::gemm_phase<pg8::EpiBf16, pg8::PanelOrder, true, true>(F.lds + RING_OFF, g, S, E); }
        } else {
            pg8::PanelOrder S; S.init(M / 256, D / 256, F.G, cid);
            S.wgm = WGM_DOWN;
            pg8::Gemm g{HB, (const pg8::bf16_t*)(ws + WS_WDD) + (size_t)ls * D * FF, M, D, FF, FF, 0};
            pg8::EpiRes E{(pg8::bf16_t*)(ws + WS_XB), D, ALPHA};
            pg8::gemm_phase<pg8::EpiRes, pg8::PanelOrder, true, true>(F.lds + RING_OFF, g, S, E);
        }
        SEAM_BAR(S4, K4);
        if constexpr (isMoe) ln_phase<false, true, layer == DEPTH - 1, false, layer == 1>(F, args.in[11] + layer * D, args.in[12] + layer * D, nullptr, 0);
        else       ln_phase<false, false, layer == DEPTH - 1, layer == 0, true>(F, args.in[11] + layer * D, args.in[12] + layer * D, nullptr, 0);
        if constexpr (layer == DEPTH - 1) return;
        SEAM_BAR(S5, K5);
        if constexpr (layer == 1) {
            pg8::Gemm g{XBc, (const pg8::bf16_t*)(ws + WS_WKV), M, NKV, D, D, 0}; pg8::PanelOrder S; S.init(M / 256, NKV / 256, F.G, cid);
            pg8::EpiKV E{(pg8::bf16_t*)(ws + WS_KS), (pg8::bf16_t*)(ws + WS_VS), (const float*)(ws + WS_COS), (const float*)(ws + WS_SIN), (float*)(ws + WS_KMEAN)};
            pg8::gemm_phase<pg8::EpiKV, pg8::PanelOrder, true, true>(F.lds + RING_OFF, g, S, E);
        }

}
#undef GRID_BAR
#undef SEAM_BAR
__global__ void __launch_bounds__(NWAVES * 64, 2) mega_fwd(Args args) {
    extern __shared__ __attribute__((aligned(16))) unsigned char lds[];
    Frame F;
    F.lds = (LAS unsigned char*)lds; F.MISC = (volatile LAS unsigned*)(F.lds + MISC_OFF);
    F.wave = __builtin_amdgcn_readfirstlane((int)threadIdx.x >> 6);
    F.G = gridDim.x; { const int bx = blockIdx.x; F.vcu = (F.G % 8 == 0) ? (bx % 8) * (F.G / 8) + bx / 8 : bx; }
    F.gw = F.vcu * NWAVES + F.wave; F.NGW = F.G * NWAVES;
    F.ws = args.ws; F.ctl = (unsigned*)(args.ws + WS_CTL); F.X = args.out; F.XB = (bf16*)(args.ws + WS_XB);
    for (int u = threadIdx.x; u < (LDS_BYTES - LDSCTL_OFF) / 4; u += NWAVES * 64) ((LAS unsigned*)(F.lds + LDSCTL_OFF))[u] = 0u;
    __syncthreads();
    XcdBarrier bar = xcd_barrier_post(F.ctl + CW_BAR, F.MISC + 8);
    if (threadIdx.x == 0) F.MISC[4] = __hip_atomic_fetch_add(F.ctl + CW_XRANK + (xb_xcc_id() & 15u) * 64, 1u, RLX_AGENT);
#define GRID_BAR() xcd_barrier(bar)

    p0_prologue(F, args);
    GRID_BAR();
    {
        if (threadIdx.x == 0) { const unsigned x = xb_xcc_id() & 15u; unsigned base = 0u;
            for (unsigned j = 0; j < 16u; ++j) { const unsigned cj = __hip_atomic_load(F.ctl + CW_XRANK + j * 64, RLX_AGENT); if (j < x) base += cj; }
            const unsigned v = base + F.MISC[4]; const unsigned per = (unsigned)F.G / 8u;
            F.MISC[5] = ((F.G % 8) == 0 && v < (unsigned)F.G) ? (v % per) * 8u + v / per : (unsigned)blockIdx.x;
            unsigned okc = (F.G == 256) ? 1u : 0u;
            for (unsigned j = 0; j < 16u; ++j) { const unsigned cj = __hip_atomic_load(F.ctl + CW_XRANK + j * 64, RLX_AGENT); if (cj != (j < 8u ? 32u : 0u)) okc = 0u; }
            F.MISC[6] = okc; }
        __syncthreads();
        F.cid = (int)F.MISC[5]; F.lok = (int)F.MISC[6];
        __syncthreads();
    }

    layer_body<0>(F, args, bar);
    layer_body<1>(F, args, bar);
    layer_body<2>(F, args, bar);
    layer_body<3>(F, args, bar);
#undef GRID_BAR
}

extern "C" void kernel_launch(void* const* d_in, const int* in_sizes, int n_in, void* d_out, int out_size, void* d_ws, size_t ws_size, hipStream_t stream) {
    static int grid = 0;
    if (grid == 0) {
        if (n_in != 18 || in_sizes[0] != M * D || out_size != M * D || ws_size < WS_END2) { fprintf(stderr, "kernel_launch: unexpected shapes / workspace (n_in %d, in0 %d, out %d, ws %zu, need %zu); nothing launched\n", n_in, n_in > 0 ? in_sizes[0] : -1, out_size, ws_size, (size_t)WS_END2); grid = -1; return; }
        int dev = 0, cus = 0, per_cu = 0;
        if (hipGetDevice(&dev) != hipSuccess || hipDeviceGetAttribute(&cus, hipDeviceAttributeMultiprocessorCount, dev) != hipSuccess) { grid = -1; return; }
        if (hipFuncSetAttribute((const void*)mega_fwd, hipFuncAttributeMaxDynamicSharedMemorySize, LDS_BYTES) != hipSuccess) { fprintf(stderr, "kernel_launch: hipFuncSetAttribute failed\n"); grid = -1; return; }
        if (hipOccupancyMaxActiveBlocksPerMultiprocessor(&per_cu, (const void*)mega_fwd, NWAVES * 64, LDS_BYTES) != hipSuccess || per_cu < 1) { fprintf(stderr, "kernel_launch: occupancy query reports %d workgroups per CU\n", per_cu); }
        (void)hipGetLastError();
        grid = cus;
    }
    if (grid < 0) return;
    if (hipMemsetAsync((char*)d_ws + WS_CTL, 0, CTL_ZERO_BYTES, stream) != hipSuccess) return;
    Args a{};
    for (int i = 0; i < 18; ++i) a.in[i] = (const float*)d_in[i];
    a.out = (float*)d_out; a.ws = (unsigned char*)d_ws;
    for (int i = 0; i < 8; ++i) a.invf[i] = pow(500000.0, -(double)i / 8.0);
    hipLaunchKernelGGL(mega_fwd, dim3(grid), dim3(NWAVES * 64), LDS_BYTES, stream, a);
}
```
